# Optimizing an MI355X kernel written in HIP

```python
import math
import jax
import jax.numpy as jnp
from jax import lax
import numpy as np

D_MODEL = 1024
BATCH = 8
SEQ = 2048
DEPTH = 4

GRID_W = 64
CTX_LEN = 256
NORM_EPS = 1e-6
N_MOD = 6

CONV_CH = 512
CONV_W = 3
MLA_HEADS = 8
Q_RANK = 256
KV_RANK = 128
QK_NOPE = 64
QK_ROPE = 32
V_HEAD = 64
MLA_SCALE = (QK_NOPE + QK_ROPE) ** -0.5
ROPE_BASE = 10000.0
Q_BLOCK = 128
EVEN_IN = 3 * CONV_CH + Q_RANK + KV_RANK + QK_ROPE
EVEN_MIX = CONV_CH + MLA_HEADS * V_HEAD
EVEN_SPLITS = (CONV_CH, 2 * CONV_CH, 3 * CONV_CH, 3 * CONV_CH + Q_RANK, 3 * CONV_CH + Q_RANK + KV_RANK)

GDN_HEADS = 8
GDN_DK = 128
GDN_DV = 128
GDN_CONV_W = 3
GDN_CHUNK = 64
GDN_QK = GDN_HEADS * GDN_DK
GDN_V = GDN_HEADS * GDN_DV
ODD_IN = 2 * GDN_QK + 2 * GDN_V + 4 * GDN_HEADS
ODD_SPLITS = (2 * GDN_QK + GDN_V, 2 * GDN_QK + 2 * GDN_V, 2 * GDN_QK + 2 * GDN_V + 2 * GDN_HEADS)

FFN_DENSE = 2816
N_EXPERTS = 8
TOP_K = 2
FFN_EXPERT = 3584

kernel_name = "hybrid_conv_mla_gdn_moe_diffusion_trunk"


def rmsnorm(x, g):
    xf = x.astype(jnp.float32)
    y = xf * lax.rsqrt(jnp.mean(xf * xf, axis=-1, keepdims=True) + NORM_EPS)
    return (y * g.astype(jnp.float32)).astype(x.dtype)


def l2norm(x):
    return x * lax.rsqrt(jnp.sum(x * x, axis=-1, keepdims=True) + NORM_EPS)


def adaln_params(cond, mod_w, mod_b):
    m = (jax.nn.silu(cond) @ mod_w + mod_b)[..., None, :]
    return jnp.split(m, N_MOD, axis=-1)


def modulate(h, shift, scale):
    return h * (1.0 + scale) + shift


def dwconv_centred(x, w):
    k_w = w.shape[0]
    pad = k_w // 2
    L = x.shape[1]
    xp = jnp.pad(x, ((0, 0), (pad, pad), (0, 0)))
    y = xp[:, 0:L] * w[0]
    for j in range(1, k_w):
        y = y + xp[:, j:j + L] * w[j]
    return y


def axial_rope_tables(row, col, dtype):
    n = QK_ROPE // 4
    inv = ROPE_BASE ** (-jnp.arange(n, dtype=jnp.float32) / n)
    ang = jnp.concatenate([row.astype(jnp.float32)[:, None] * inv, col.astype(jnp.float32)[:, None] * inv], axis=-1)
    return jnp.cos(ang).astype(dtype), jnp.sin(ang).astype(dtype)


def apply_axial_rope(x, cos, sin):
    q = x.shape[-1] // 4
    x1, x2, x3, x4 = jnp.split(x, 4, axis=-1)
    a = jnp.concatenate([x1, x3], axis=-1)
    b = jnp.concatenate([x2, x4], axis=-1)
    ra = a * cos - b * sin
    rb = b * cos + a * sin
    return jnp.concatenate([ra[..., :q], rb[..., :q], ra[..., q:], rb[..., q:]], axis=-1)


def mla_attend(q_nope, q_rope, k_nope, k_rope, v):
    s = jnp.einsum("bqhd,bkhd->bhqk", q_nope, k_nope) + jnp.einsum("bqhr,bkr->bhqk", q_rope, k_rope)
    p = jax.nn.softmax(s.astype(jnp.float32) * MLA_SCALE, axis=-1).astype(v.dtype)
    return jnp.einsum("bhqk,bkhd->bqhd", p, v)


def latent_attention(q_nope, q_rope, k_nope, k_rope, v):
    b, L = q_nope.shape[:2]
    nb = L // Q_BLOCK

    def blocks(t):
        return jnp.moveaxis(t.reshape(b, nb, Q_BLOCK, *t.shape[2:]), 1, 0)

    out = lax.map(lambda qs: mla_attend(qs[0], qs[1], k_nope, k_rope, v), (blocks(q_nope), blocks(q_rope)))
    return jnp.moveaxis(out, 0, 1).reshape(b, L, MLA_HEADS * V_HEAD)


def unit_lower_inverse(lm):
    eye = jnp.eye(lm.shape[-1], dtype=lm.dtype)
    p = -lm
    t = eye + p
    for _ in range((lm.shape[-1] - 1).bit_length() - 1):
        p = p @ p
        t = t @ (eye + p)
    return t


def gated_delta_chunked(q, k, v, g, beta, state):
    b, L, h, _ = k.shape
    dv = v.shape[-1]
    n = L // GDN_CHUNK

    def chunks(t):
        return jnp.swapaxes(t.reshape(b, n, GDN_CHUNK, *t.shape[2:]), 2, 3)

    q, k, v, g, beta = (chunks(t) for t in (q, k, v, g, beta))
    gcum = jnp.cumsum(g, axis=-1)
    incl = jnp.tril(jnp.ones((GDN_CHUNK, GDN_CHUNK), dtype=bool))
    decay = jnp.exp(jnp.where(incl, gcum[..., :, None] - gcum[..., None, :], -jnp.inf))
    kb = k * beta[..., None]
    strict = jnp.tril(jnp.einsum("bnhid,bnhjd->bnhij", kb, k) * decay, -1)
    tinv = unit_lower_inverse(strict)
    u = tinv @ (v * beta[..., None])
    w = tinv @ (kb * jnp.exp(gcum)[..., None])
    attn = jnp.einsum("bnhid,bnhjd->bnhij", q, k) * decay
    qg = q * jnp.exp(gcum)[..., None]
    kd = k * jnp.exp(gcum[..., -1:] - gcum)[..., None]
    gend = jnp.exp(gcum[..., -1])[..., None, None]

    def step(s, xs):
        u_i, w_i, a_i, qg_i, kd_i, ge_i = xs
        v_new = u_i - w_i @ s
        o_i = qg_i @ s + a_i @ v_new
        s = s * ge_i + jnp.swapaxes(kd_i, -1, -2) @ v_new
        return s, o_i

    xs = tuple(jnp.moveaxis(t, 1, 0) for t in (u, w, attn, qg, kd, gend))
    state, o = lax.scan(step, state, xs)
    o = jnp.swapaxes(jnp.moveaxis(o, 0, 1), 2, 3).reshape(b, L, h, dv)
    return o, state


def scan_direction(q, k, v, g, beta, state, reverse):
    if reverse:
        o, s = gated_delta_chunked(*(jnp.flip(t, 1) for t in (q, k, v, g, beta)), state)
        return jnp.flip(o, 1), s
    return gated_delta_chunked(q, k, v, g, beta, state)


def swiglu(h, w1, w2):
    gate, up = jnp.split(h @ w1, 2, axis=-1)
    return (jax.nn.silu(gate) * up) @ w2


def moe_swiglu(h, router_w, w1, w2):
    logits = (h @ router_w).astype(jnp.float32)
    top_v, top_i = lax.top_k(logits, TOP_K)
    top_w = jax.nn.softmax(top_v, axis=-1)
    gates = jnp.sum(jax.nn.one_hot(top_i, N_EXPERTS, dtype=jnp.float32) * top_w[..., None], axis=-2).astype(h.dtype)
    y = gates[..., 0:1] * swiglu(h, w1[0], w2[0])
    for e in range(1, N_EXPERTS):
        y = y + gates[..., e:e + 1] * swiglu(h, w1[e], w2[e])
    return y


def even_mixer(hc, hx, cos, sin, w_in, conv_w, q_norm_g, w_uq, kv_norm_g, w_ukv, w_out, ctx_out):
    def project(h):
        b, L = h.shape[:2]
        gb, gc, u, cq, ckv, kr = jnp.split(h @ w_in, EVEN_SPLITS, axis=-1)
        conv_y = gb * dwconv_centred(gc * u, conv_w)
        q = (rmsnorm(cq, q_norm_g) @ w_uq).reshape(b, L, MLA_HEADS, QK_NOPE + QK_ROPE)
        kv = (rmsnorm(ckv, kv_norm_g) @ w_ukv).reshape(b, L, MLA_HEADS, QK_NOPE + V_HEAD)
        return conv_y, q[..., :QK_NOPE], q[..., QK_NOPE:], kv[..., :QK_NOPE], kr, kv[..., QK_NOPE:]

    cy_c, qn_c, qr_c, kn_c, kr_c, v_c = project(hc)
    cy_x, qn_x, qr_x, kn_x, kr_x, v_x = project(hx)
    qr_x = apply_axial_rope(qr_x, cos[:, None, :], sin[:, None, :])
    kr_x = apply_axial_rope(kr_x, cos, sin)
    k_nope = jnp.concatenate([kn_c, kn_x], axis=1)
    k_rope = jnp.concatenate([kr_c, kr_x], axis=1)
    v = jnp.concatenate([v_c, v_x], axis=1)
    att_x = latent_attention(qn_x, qr_x, k_nope, k_rope, v)
    out_x = jnp.concatenate([cy_x, att_x], axis=-1) @ w_out
    out_c = None
    if ctx_out:
        b, lc = hc.shape[:2]
        att_c = mla_attend(qn_c, qr_c, kn_c, kr_c, v_c).reshape(b, lc, MLA_HEADS * V_HEAD)
        out_c = jnp.concatenate([cy_c, att_c], axis=-1) @ w_out
    return out_c, out_x


def odd_mixer(hc, hx, w_in, qkv_conv_w, a_log, dt_bias, o_norm_g, w_out, ctx_out):
    def project(h):
        b, L = h.shape[:2]
        qkv, gate, a, bt = jnp.split(h @ w_in, ODD_SPLITS, axis=-1)
        qkv = jax.nn.silu(dwconv_centred(qkv, qkv_conv_w)).astype(jnp.float32)
        q, k, v = jnp.split(qkv, (GDN_QK, 2 * GDN_QK), axis=-1)
        q = l2norm(q.reshape(b, L, GDN_HEADS, GDN_DK)) * (GDN_DK ** -0.5)
        k = l2norm(k.reshape(b, L, GDN_HEADS, GDN_DK))
        v = v.reshape(b, L, GDN_HEADS, GDN_DV)
        a = a.astype(jnp.float32).reshape(b, L, 2, GDN_HEADS)
        g = -jnp.exp(a_log.astype(jnp.float32)) * jax.nn.softplus(a + dt_bias.astype(jnp.float32))
        beta = jax.nn.sigmoid(bt.astype(jnp.float32).reshape(b, L, 2, GDN_HEADS))
        return q, k, v, g, beta, gate.reshape(b, L, GDN_HEADS, GDN_DV)

    def output(o, gate, dtype):
        b, L = o.shape[:2]
        y = rmsnorm(o, o_norm_g) * jax.nn.silu(gate.astype(jnp.float32))
        return y.reshape(b, L, GDN_V).astype(dtype) @ w_out

    qc, kc, vc, gcc, bc, zc = project(hc)
    qx, kx, vx, gx, bx, zx = project(hx)
    s0 = jnp.zeros((hx.shape[0], GDN_HEADS, GDN_DK, GDN_DV), jnp.float32)
    oc_f, sc_f = scan_direction(qc, kc, vc, gcc[:, :, 0], bc[:, :, 0], s0, False)
    oc_b, sc_b = scan_direction(qc, kc, vc, gcc[:, :, 1], bc[:, :, 1], s0, True)
    ox_f, _ = scan_direction(qx, kx, vx, gx[:, :, 0], bx[:, :, 0], sc_f, False)
    ox_b, _ = scan_direction(qx, kx, vx, gx[:, :, 1], bx[:, :, 1], sc_b, True)
    out_x = output(ox_f + ox_b, zx, hx.dtype)
    out_c = output(oc_f + oc_b, zc, hc.dtype) if ctx_out else None
    return out_c, out_x


def trunk_layer(x, ctx, c, c_ctx, mod_w, mod_b, norm1_g, norm2_g, mixer, ffn, ctx_out):
    sx1, ax1, gx1, sx2, ax2, gx2 = adaln_params(c, mod_w, mod_b)
    sc1, ac1, gc1, sc2, ac2, gc2 = adaln_params(c_ctx, mod_w, mod_b)
    hx = modulate(rmsnorm(x, norm1_g), sx1, ax1)
    hc = modulate(rmsnorm(ctx, norm1_g), sc1, ac1)
    oc, ox = mixer(hc, hx)
    x = x + gx1 * ox
    hx = modulate(rmsnorm(x, norm2_g), sx2, ax2)
    if ctx_out:
        ctx = ctx + gc1 * oc
        hc = modulate(rmsnorm(ctx, norm2_g), sc2, ac2)
        lc = ctx.shape[1]
        y = ffn(jnp.concatenate([hc, hx], axis=1))
        ctx = ctx + gc2 * y[:, :lc]
        x = x + gx2 * y[:, lc:]
    else:
        x = x + gx2 * ffn(hx)
    return x, ctx


def even_layer(x, ctx, c, c_ctx, cos, sin, mod_w, mod_b, norm1_g, w_in, conv_w, q_norm_g, w_uq, kv_norm_g,
               w_ukv, w_out, norm2_g, ffn_w1, ffn_w2, ctx_out):
    mixer = lambda hc, hx: even_mixer(hc, hx, cos, sin, w_in, conv_w, q_norm_g, w_uq, kv_norm_g, w_ukv, w_out, ctx_out)
    ffn = lambda h: swiglu(h, ffn_w1, ffn_w2)
    return trunk_layer(x, ctx, c, c_ctx, mod_w, mod_b, norm1_g, norm2_g, mixer, ffn, ctx_out)


def odd_layer(x, ctx, c, c_ctx, mod_w, mod_b, norm1_g, w_in, qkv_conv_w, a_log, dt_bias, o_norm_g, w_out,
              norm2_g, router_w, moe_w1, moe_w2, ctx_out):
    mixer = lambda hc, hx: odd_mixer(hc, hx, w_in, qkv_conv_w, a_log, dt_bias, o_norm_g, w_out, ctx_out)
    ffn = lambda h: moe_swiglu(h, router_w, moe_w1, moe_w2)
    return trunk_layer(x, ctx, c, c_ctx, mod_w, mod_b, norm1_g, norm2_g, mixer, ffn, ctx_out)


def setup_inputs(seed: int = 0) -> dict:
    base = jax.random.key(seed)
    counter = iter(range(100000))

    def nk():
        return jax.random.fold_in(base, next(counter))

    def normal(shape, scale):
        return scale * jax.random.normal(nk(), shape, jnp.float32)

    def gain(n):
        return 1.0 + normal((n,), 0.02)

    d = D_MODEL
    inp = {}
    inp["x"] = normal((BATCH, SEQ, d), 1.0)
    inp["c"] = normal((BATCH, d), 1.0)
    inp["ctx"] = normal((BATCH, CTX_LEN, d), 1.0)
    inp["c_ctx"] = normal((d,), 1.0)
    for i in range(DEPTH):
        p = "l%d_" % i
        inp[p + "mod_w"] = normal((d, N_MOD * d), 0.5 * d ** -0.5)
        inp[p + "mod_b"] = normal((N_MOD * d,), 0.02)
        inp[p + "norm1_g"] = gain(d)
        if i % 2 == 0:
            inp[p + "w_in"] = normal((d, EVEN_IN), d ** -0.5)
            inp[p + "conv_w"] = normal((CONV_W, CONV_CH), CONV_W ** -0.5)
            inp[p + "q_norm_g"] = gain(Q_RANK)
            inp[p + "w_uq"] = normal((Q_RANK, MLA_HEADS * (QK_NOPE + QK_ROPE)), Q_RANK ** -0.5)
            inp[p + "kv_norm_g"] = gain(KV_RANK)
            inp[p + "w_ukv"] = normal((KV_RANK, MLA_HEADS * (QK_NOPE + V_HEAD)), KV_RANK ** -0.5)
            inp[p + "w_out"] = normal((EVEN_MIX, d), EVEN_MIX ** -0.5)
            inp[p + "norm2_g"] = gain(d)
            inp[p + "ffn_w1"] = normal((d, 2 * FFN_DENSE), d ** -0.5)
            inp[p + "ffn_w2"] = normal((FFN_DENSE, d), FFN_DENSE ** -0.5)
        else:
            inp[p + "w_in"] = normal((d, ODD_IN), d ** -0.5)
            inp[p + "qkv_conv_w"] = normal((GDN_CONV_W, 2 * GDN_QK + GDN_V), GDN_CONV_W ** -0.5)
            inp[p + "a_log"] = jnp.log(jax.random.uniform(nk(), (2, GDN_HEADS), jnp.float32, 1.0, 16.0))
            dt = jnp.exp(jax.random.uniform(nk(), (2, GDN_HEADS), jnp.float32, math.log(1e-3), math.log(1e-1)))
            inp[p + "dt_bias"] = dt + jnp.log(-jnp.expm1(-dt))
            inp[p + "o_norm_g"] = gain(GDN_DV)
            inp[p + "w_out"] = normal((GDN_V, d), GDN_V ** -0.5)
            inp[p + "norm2_g"] = gain(d)
            inp[p + "router_w"] = normal((d, N_EXPERTS), d ** -0.5)
            inp[p + "moe_w1"] = normal((N_EXPERTS, d, 2 * FFN_EXPERT), d ** -0.5)
            inp[p + "moe_w2"] = normal((N_EXPERTS, FFN_EXPERT, d), FFN_EXPERT ** -0.5)
    inp["final_norm_g"] = gain(d)
    return inp


def reference(x, c, ctx, c_ctx,
              l0_mod_w, l0_mod_b, l0_norm1_g, l0_w_in, l0_conv_w, l0_q_norm_g, l0_w_uq, l0_kv_norm_g, l0_w_ukv,
              l0_w_out, l0_norm2_g, l0_ffn_w1, l0_ffn_w2,
              l1_mod_w, l1_mod_b, l1_norm1_g, l1_w_in, l1_qkv_conv_w, l1_a_log, l1_dt_bias, l1_o_norm_g,
              l1_w_out, l1_norm2_g, l1_router_w, l1_moe_w1, l1_moe_w2,
              l2_mod_w, l2_mod_b, l2_norm1_g, l2_w_in, l2_conv_w, l2_q_norm_g, l2_w_uq, l2_kv_norm_g, l2_w_ukv,
              l2_w_out, l2_norm2_g, l2_ffn_w1, l2_ffn_w2,
              l3_mod_w, l3_mod_b, l3_norm1_g, l3_w_in, l3_qkv_conv_w, l3_a_log, l3_dt_bias, l3_o_norm_g,
              l3_w_out, l3_norm2_g, l3_router_w, l3_moe_w1, l3_moe_w2,
              final_norm_g):
    rows = x.shape[1] // GRID_W
    row = jnp.repeat(jnp.arange(rows), GRID_W)
    col = jnp.tile(jnp.arange(GRID_W), rows)
    cos, sin = axial_rope_tables(row, col, x.dtype)
    layers = (
        (l0_mod_w, l0_mod_b, l0_norm1_g, l0_w_in, l0_conv_w, l0_q_norm_g, l0_w_uq, l0_kv_norm_g, l0_w_ukv,
         l0_w_out, l0_norm2_g, l0_ffn_w1, l0_ffn_w2),
        (l1_mod_w, l1_mod_b, l1_norm1_g, l1_w_in, l1_qkv_conv_w, l1_a_log, l1_dt_bias, l1_o_norm_g,
         l1_w_out, l1_norm2_g, l1_router_w, l1_moe_w1, l1_moe_w2),
        (l2_mod_w, l2_mod_b, l2_norm1_g, l2_w_in, l2_conv_w, l2_q_norm_g, l2_w_uq, l2_kv_norm_g, l2_w_ukv,
         l2_w_out, l2_norm2_g, l2_ffn_w1, l2_ffn_w2),
        (l3_mod_w, l3_mod_b, l3_norm1_g, l3_w_in, l3_qkv_conv_w, l3_a_log, l3_dt_bias, l3_o_norm_g,
         l3_w_out, l3_norm2_g, l3_router_w, l3_moe_w1, l3_moe_w2),
    )
    for i in range(DEPTH):
        ctx_out = i < DEPTH - 1
        if i % 2 == 0:
            x, ctx = even_layer(x, ctx, c, c_ctx, cos, sin, *layers[i], ctx_out=ctx_out)
        else:
            x, ctx = odd_layer(x, ctx, c, c_ctx, *layers[i], ctx_out=ctx_out)
    return rmsnorm(x, final_norm_g)
```

```cpp
#include <hip/hip_runtime.h>
#include <cstdio>
#include <cstdint>

#ifndef N_LAUNCH_MODE
#define N_LAUNCH_MODE 1
#endif
#ifndef DBG_CHECK
#define DBG_CHECK 0
#endif

#define LAS __attribute__((address_space(3)))
#define GAS __attribute__((address_space(1)))
typedef unsigned short bf16;
typedef short bf16x8 __attribute__((ext_vector_type(8)));
typedef short s16x4 __attribute__((ext_vector_type(4)));
typedef float f32x4 __attribute__((ext_vector_type(4)));
typedef float f32x2 __attribute__((ext_vector_type(2)));
typedef unsigned u32x4 __attribute__((ext_vector_type(4)));
typedef unsigned u32x2 __attribute__((ext_vector_type(2)));
#define DI __device__ __forceinline__

constexpr int D = 1024, NB = 8, SEQ = 2048, CTXL = 256, LT = SEQ + CTXL  , T = NB * LT  ;
constexpr float NORM_EPS = 1e-6f;
constexpr int EVEN_IN = 1952, EVEN_INP = 2048, UP_K = 384, UP_N = 1792, FFN_F = 2816;
constexpr int ODD_IN = 4128, ODD_INP = 4352, MOE_F = 3584, NEXP = 8;
constexpr int MOE_ROWS = 2 * T + NEXP * 256;
constexpr int NWAVES = 8, NTHR = 512;
constexpr float QSCALE = 0.10206207261596575f * 1.4426950408889634f;

constexpr int IN_X = 0, IN_C = 1, IN_CTX = 2, IN_CCTX = 3, IN_FINAL = 56;
#define LIN(l, j) (4 + 13 * (l) + (j))

constexpr size_t MiB = 1u << 20;
constexpr size_t WS_CTL = 0, CTL_ZERO_BYTES = 1 * MiB;
constexpr size_t WS_MOD = 1 * MiB;
constexpr size_t WS_ROPE = 2 * MiB;
constexpr size_t WS_TOK = 3 * MiB;
constexpr size_t WS_LIST = 4 * MiB;
constexpr size_t WS_GW = 5 * MiB;
constexpr size_t WS_AB = 6 * MiB;
constexpr size_t WS_GB = 9 * MiB;
constexpr size_t WS_GEND = 12 * MiB;
constexpr size_t WS_KR = 13 * MiB;
constexpr size_t WS_DBG = 15 * MiB;
constexpr size_t WS_XS = 16 * MiB;
constexpr size_t WS_H = 88 * MiB;
constexpr size_t WS_W = 124 * MiB;
constexpr size_t WS_WO = 149 * MiB;
constexpr size_t WS_R0 = 328 * MiB;
constexpr size_t WS_R1 = 652 * MiB;
constexpr size_t WS_R2 = 760 * MiB;
constexpr size_t WS_END = 796 * MiB;
constexpr size_t WE_IN = 0, WE_UP = 4 * MiB, WE_OUT = 6 * MiB, WE_W1 = 8 * MiB, WE_W2 = 19 * MiB;
constexpr size_t WO_IN = 0, WO_OUT = 9 * MiB, WO_W1 = 11 * MiB, WO_W2 = 123 * MiB;
constexpr size_t RE_P = 0, RE_MIX = 72 * MiB, RE_A2 = 108 * MiB, RE_Q = 122 * MiB, RE_KN = 149 * MiB, RE_VT = 167 * MiB, RE_ACT = 185 * MiB;
constexpr size_t CL_BYTES = 73728;
constexpr size_t CL_W = 0, CL_QG = 16384, CL_KDT = 32768, CL_ATT = 49152, CL_UT = 57344;
constexpr int CW_TMO = 0, CW_BAR = 4096, CW_CNT = 8192  , CW_CHK = 12288, CW_WGSUM = 16384  , CW_WCNT = 32768  ;

DI float bf2f(unsigned v) { return __uint_as_float(v << 16); }
typedef __bf16 bf16x2_t __attribute__((ext_vector_type(2)));
DI unsigned cvt_pk_bf16(float lo, float hi) { const f32x2 v = {lo, hi}; const bf16x2_t b = __builtin_convertvector(v, bf16x2_t); return __builtin_bit_cast(unsigned, b); }
DI unsigned f2bf(float f) { return cvt_pk_bf16(f, 0.f) & 0xffffu; }
template <int CTRL> DI float dpp_f(float v) { return __builtin_bit_cast(float, __builtin_amdgcn_update_dpp(0, __builtin_bit_cast(int, v), CTRL, 0xf, 0xf, true)); }
template <int CTRL> DI unsigned dpp_u(unsigned v) { return (unsigned)__builtin_amdgcn_update_dpp(0, (int)v, CTRL, 0xf, 0xf, true); }
DI float sum8(float v) { v += dpp_f<0xB1>(v); v += dpp_f<0x4E>(v); v += dpp_f<0x141>(v); return v; }
DI float sum16(float v) { v = sum8(v); v += dpp_f<0x140>(v); return v; }
DI float wave_sum(float v) {
    v = sum16(v);
    { const auto r = __builtin_amdgcn_permlane16_swap(__float_as_uint(v), __float_as_uint(v), false, false); v = __uint_as_float(r[0]) + __uint_as_float(r[1]); }
    { const auto r = __builtin_amdgcn_permlane32_swap(__float_as_uint(v), __float_as_uint(v), false, false); v = __uint_as_float(r[0]) + __uint_as_float(r[1]); }
    return v;
}
DI unsigned wave_sum_u(unsigned v) {
    v += dpp_u<0xB1>(v); v += dpp_u<0x4E>(v); v += dpp_u<0x141>(v); v += dpp_u<0x140>(v);
    { const auto r = __builtin_amdgcn_permlane16_swap(v, v, false, false); v = r[0] + r[1]; }
    { const auto r = __builtin_amdgcn_permlane32_swap(v, v, false, false); v = r[0] + r[1]; }
    return v;
}
DI float silu_f(float x) { return x * __builtin_amdgcn_rcpf(1.f + __expf(-x)); }
#define LDS_WAIT() asm volatile("s_waitcnt lgkmcnt(0)" ::: "memory")
#define VM_WAIT() asm volatile("s_waitcnt vmcnt(0)" ::: "memory")

namespace pg8 {
constexpr int BM = 256, BK = 64, HALF = 128, HTB = HALF * BK * 2, STAGE_BYTES = 8 * HTB, NXCD = 8, WGM = 8;
__host__ __device__ __forceinline__ int lds_byte(int r, int c) { const int st = (r >> 4) * 2 + (c >> 5), rr = r & 15, cc = c & 31, ob = rr * 64 + cc * 2; return st * 1024 + (ob ^ (((ob >> 9) & 1) << 5)); }
__host__ __device__ __forceinline__ void stage_rc(int b, int& R, int& C) { const int st = b / 1024, sb = b % 1024, swz = sb ^ (((sb >> 9) & 1) << 5); R = (st >> 1) * 16 + swz / 64; C = (st & 1) * 32 + (swz % 64) / 2; }
__host__ __device__ __forceinline__ int perm32(int rho) { const int n = rho >> 4, i = rho & 15; return 8 * (i >> 2) + 4 * n + (i & 3); }

struct Unit { int pm, pn, e, cnt, aux; };

struct DenseOrder {
    static constexpr bool GATHER = false;
    const bf16* A; const bf16* Bt; int lda, ldb;
    int nM, nN, nwg, G, c, skipctx;
    DI void init(const bf16* A_, int lda_, const bf16* Bt_, int ldb_, int M, int N, int G_, int c_, int skipctx_ = 0) { A = A_; Bt = Bt_; lda = lda_; ldb = ldb_; nM = M / BM; nN = N / BM; skipctx = skipctx_; if (skipctx) nM = nM / 9 * 8; nwg = nM * nN; G = G_; c = c_; }
    DI bool next(int i, Unit& u) const {
        const long L = (long)i * G + c; if (L >= nwg) return false;
        int wgid = (int)L; { const int q = nwg / NXCD, r = nwg % NXCD, xcd = wgid % NXCD, off = wgid / NXCD; wgid = (xcd < r ? xcd * (q + 1) : r * (q + 1) + (xcd - r) * q) + off; }
        const int nig = WGM * nN, gid = wgid / nig, fm = gid * WGM, gsz = (nM - fm) < WGM ? (nM - fm) : WGM;
        u.pm = fm + ((wgid % nig) % gsz); u.pn = (wgid % nig) / gsz; u.e = 0; u.cnt = 256;
        if (skipctx) u.pm = (u.pm >> 3) * 9 + 1 + (u.pm & 7);
        return true;
    }
    DI const char* abase(const Unit& u) const { return (const char*)A + (size_t)u.pm * 256 * lda * 2; }
    DI const char* bbase(const Unit& u) const { return (const char*)Bt + (size_t)u.pn * 256 * ldb * 2; }
    DI unsigned arow(const Unit&, int) const { return 0u; }
};

template <class Epi, class Sched, int K, int lda, int ldb, bool ALIGN_EPI = true, bool SP2 = true>
__device__ __forceinline__ void gemm_phase(LAS unsigned char* lds, const Sched& S, const Epi& E) {
    int tid = threadIdx.x; asm volatile("" : "+v"(tid));
    const int wid = __builtin_amdgcn_readfirstlane(tid >> 6), lane = tid & 63, wr = wid >> 2, wc = wid & 3, fr = lane & 15, fq = lane >> 4;
    constexpr int nt = K / BK;
    unsigned voffA[2], voffB[2]; int RA[2], CA[2];
#pragma unroll
    for (int i = 0; i < 2; ++i) { int R, C; stage_rc(tid * 16 + i * 8192, R, C); const int Rb = Epi::PERM ? ((R & ~31) + perm32(R & 31)) : R;
        RA[i] = R; CA[i] = C; voffA[i] = (unsigned)(R * lda + C) * 2u; voffB[i] = (unsigned)(Rb * ldb + C) * 2u; }
    const size_t kstep = (size_t)(BK * 2);
    const size_t hstepA = (size_t)HALF * lda * 2, hstepB = (size_t)HALF * ldb * 2;
    const unsigned ldsw = (unsigned)wid * 1024u;
    const int aoff = lds_byte(wr * 64 + fr, fq * 8), boff = lds_byte(wc * 32 + fr, fq * 8);
#define PG8_SA(b, h) (((b) * 2 + (h)) * HTB)
#define PG8_SB(b, h) ((4 + (b) * 2 + (h)) * HTB)
#define PG8_STAGE(bufoff, gbase, voff) do { _Pragma("unroll") for (int _i = 0; _i < 2; ++_i) \
        __builtin_amdgcn_global_load_lds((const unsigned*)((const char*)(gbase) + (voff)[_i]), (LAS unsigned*)(lds + (bufoff) + ldsw + _i * 8192), 16, 0, 0); } while (0)
#define PG8_STAGE_A(bufoff, gbase, h, offs) do { if constexpr (Sched::GATHER) { PG8_STAGE(bufoff, gbase, (offs)[h]); } else { PG8_STAGE(bufoff, (gbase) + (h) * hstepA, voffA); } } while (0)
#define PG8_LDA(dst, b, h) do { _Pragma("unroll") for (int m = 0; m < 4; ++m) _Pragma("unroll") for (int k = 0; k < 2; ++k) dst[m][k] = *(const LAS bf16x8*)(lds + PG8_SA(b, h) + aoff + m * 2048 + k * 1024); } while (0)
#define PG8_LDB(dst, b, h) do { _Pragma("unroll") for (int n = 0; n < 2; ++n) _Pragma("unroll") for (int k = 0; k < 2; ++k) dst[n][k] = *(const LAS bf16x8*)(lds + PG8_SB(b, h) + boff + n * 2048 + k * 1024); } while (0)
#define PG8_MMA(ai, bj, At, Bt) do { __builtin_amdgcn_s_setprio(1); _Pragma("unroll") for (int m = 0; m < 4; ++m) _Pragma("unroll") for (int n = 0; n < 2; ++n) _Pragma("unroll") for (int k = 0; k < 2; ++k) \
        acc[ai][bj][m][n] = __builtin_amdgcn_mfma_f32_16x16x32_bf16(Bt[n][k], At[m][k], acc[ai][bj][m][n], 0, 0, 0); __builtin_amdgcn_s_setprio(0); } while (0)
#define PG8_WAIT_V(n) asm volatile("s_waitcnt vmcnt(" #n ")" ::: "memory")
#define PG8_WAIT_L(n) asm volatile("s_waitcnt lgkmcnt(" #n ")" ::: "memory")
#define PG8_BAR __builtin_amdgcn_s_barrier()
#define PG8_SCHED __builtin_amdgcn_sched_barrier(0)
    Unit cur, nxt; int ui = 0;
    if (!S.next(0, cur)) return;
    f32x4 acc[2][2][4][2];
#pragma unroll
    for (int a = 0; a < 2; ++a)
#pragma unroll
        for (int b = 0; b < 2; ++b)
#pragma unroll
            for (int m = 0; m < 4; ++m)
#pragma unroll
                for (int n = 0; n < 2; ++n) acc[a][b][m][n] = (f32x4){0.f, 0.f, 0.f, 0.f};
    bf16x8 At[4][2], B0[2][2], B1[2][2];
    unsigned cOff[2][2], nOff[2][2];
    if constexpr (Sched::GATHER) {
#pragma unroll
        for (int h = 0; h < 2; ++h)
#pragma unroll
            for (int i = 0; i < 2; ++i) { cOff[h][i] = S.arow(cur, h * HALF + RA[i]) + (unsigned)CA[i] * 2u; nOff[h][i] = cOff[h][i]; }
        asm volatile("" : "+v"(cOff[0][0]), "+v"(cOff[0][1]), "+v"(cOff[1][0]), "+v"(cOff[1][1]));
    }
    const char* cA = S.abase(cur); const char* cB = S.bbase(cur);
    if constexpr (SP2) {
        PG8_STAGE(PG8_SB(0, 0), cB, voffB); PG8_STAGE(PG8_SB(0, 1), cB + hstepB, voffB); PG8_STAGE_A(PG8_SA(0, 0), cA, 0, cOff); PG8_STAGE_A(PG8_SA(0, 1), cA, 1, cOff);
        if (wr == 1) PG8_BAR;
        PG8_WAIT_V(2); PG8_BAR;
        PG8_STAGE(PG8_SB(1, 0), cB + kstep, voffB); PG8_STAGE_A(PG8_SA(1, 0), cA + kstep, 0, cOff); PG8_STAGE(PG8_SB(1, 1), cB + hstepB + kstep, voffB);
        PG8_WAIT_V(6); PG8_BAR;
    } else {
        PG8_STAGE(PG8_SB(0, 0), cB, voffB); PG8_STAGE_A(PG8_SA(0, 0), cA, 0, cOff); PG8_STAGE(PG8_SB(0, 1), cB + hstepB, voffB); PG8_STAGE_A(PG8_SA(0, 1), cA, 1, cOff);
        if (wr == 1) PG8_BAR;
        PG8_WAIT_V(4); PG8_BAR;
        PG8_STAGE(PG8_SB(1, 0), cB + kstep, voffB); PG8_STAGE_A(PG8_SA(1, 0), cA + kstep, 0, cOff); PG8_STAGE(PG8_SB(1, 1), cB + hstepB + kstep, voffB);
        PG8_WAIT_V(6); PG8_BAR;
    }
    for (;;) {
        const bool has_next = S.next(ui + 1, nxt);
        const char* nA = has_next ? S.abase(nxt) : cA; const char* nB = has_next ? S.bbase(nxt) : cB;
        if constexpr (Sched::GATHER) {
            if (has_next) {
#pragma unroll
                for (int h = 0; h < 2; ++h)
#pragma unroll
                    for (int i = 0; i < 2; ++i) nOff[h][i] = S.arow(nxt, h * HALF + RA[i]) + (unsigned)CA[i] * 2u;
                asm volatile("" : "+v"(nOff[0][0]), "+v"(nOff[0][1]), "+v"(nOff[1][0]), "+v"(nOff[1][1]));
            }
        }
        for (int t = 0; t < nt; t += 2) {
            const bool last = (t == nt - 2);
            const char* a1 = cA + (size_t)(t + 1) * kstep;
            const char* a2 = last ? nA : cA + (size_t)(t + 2) * kstep; const char* b2 = last ? nB : cB + (size_t)(t + 2) * kstep;
            const char* a3 = a2 + kstep; const char* b3 = b2 + kstep;
            unsigned o2[2][2];
            if constexpr (Sched::GATHER) {
#pragma unroll
                for (int h = 0; h < 2; ++h)
#pragma unroll
                    for (int i = 0; i < 2; ++i) o2[h][i] = last ? nOff[h][i] : cOff[h][i];
            }
            if constexpr (SP2) {
            PG8_LDB(B0, 0, 0); PG8_LDB(B1, 0, 1); PG8_SCHED; PG8_LDA(At, 0, 0); PG8_STAGE_A(PG8_SA(1, 1), a1, 1, cOff);
            PG8_WAIT_V(8); PG8_WAIT_L(0); PG8_BAR; PG8_MMA(0, 0, At, B0); PG8_MMA(0, 1, At, B1); PG8_BAR; PG8_SCHED;
            PG8_LDA(At, 0, 1); PG8_STAGE(PG8_SB(0, 0), b2, voffB); PG8_STAGE(PG8_SB(0, 1), b2 + hstepB, voffB); PG8_STAGE_A(PG8_SA(0, 0), a2, 0, o2);
            PG8_WAIT_V(8); PG8_WAIT_L(0); PG8_BAR; PG8_MMA(1, 0, At, B0); PG8_MMA(1, 1, At, B1); PG8_BAR; PG8_SCHED;
            PG8_LDB(B0, 1, 0); PG8_LDB(B1, 1, 1); PG8_SCHED; PG8_LDA(At, 1, 0); PG8_STAGE_A(PG8_SA(0, 1), a2, 1, o2);
            PG8_WAIT_V(8); PG8_WAIT_L(0); PG8_BAR; PG8_MMA(0, 0, At, B0); PG8_MMA(0, 1, At, B1); PG8_BAR; PG8_SCHED;
            PG8_LDA(At, 1, 1); PG8_STAGE(PG8_SB(1, 0), b3, voffB); PG8_STAGE(PG8_SB(1, 1), b3 + hstepB, voffB); PG8_STAGE_A(PG8_SA(1, 0), a3, 0, o2);
            PG8_WAIT_V(8); PG8_WAIT_L(0); PG8_BAR; PG8_MMA(1, 0, At, B0); PG8_MMA(1, 1, At, B1); PG8_BAR; PG8_SCHED;
            } else {
            PG8_LDB(B0, 0, 0); PG8_SCHED; PG8_LDA(At, 0, 0); PG8_STAGE_A(PG8_SA(1, 1), a1, 1, cOff);
            PG8_WAIT_L(8); PG8_BAR; PG8_WAIT_L(0); PG8_MMA(0, 0, At, B0); PG8_BAR; PG8_SCHED;
            PG8_LDB(B1, 0, 1); PG8_STAGE(PG8_SB(0, 0), b2, voffB);
            PG8_BAR; PG8_WAIT_L(0); PG8_MMA(0, 1, At, B1); PG8_BAR;
            PG8_LDA(At, 0, 1); PG8_STAGE_A(PG8_SA(0, 0), a2, 0, o2);
            PG8_BAR; PG8_WAIT_L(0); PG8_MMA(1, 0, At, B0); PG8_BAR; PG8_SCHED;
            PG8_STAGE(PG8_SB(0, 1), b2 + hstepB, voffB);
            PG8_WAIT_V(6); PG8_BAR; PG8_MMA(1, 1, At, B1); PG8_BAR;
            PG8_LDB(B0, 1, 0); PG8_SCHED; PG8_LDA(At, 1, 0); PG8_STAGE_A(PG8_SA(0, 1), a2, 1, o2);
            PG8_WAIT_L(8); PG8_BAR; PG8_WAIT_L(0); PG8_MMA(0, 0, At, B0); PG8_BAR; PG8_SCHED;
            PG8_LDB(B1, 1, 1); PG8_STAGE(PG8_SB(1, 0), b3, voffB);
            PG8_BAR; PG8_WAIT_L(0); PG8_MMA(0, 1, At, B1); PG8_BAR;
            PG8_LDA(At, 1, 1); PG8_STAGE_A(PG8_SA(1, 0), a3, 0, o2);
            PG8_BAR; PG8_WAIT_L(0); PG8_MMA(1, 0, At, B0); PG8_BAR; PG8_SCHED;
            PG8_STAGE(PG8_SB(1, 1), b3 + hstepB, voffB);
            PG8_WAIT_V(6); PG8_BAR; PG8_MMA(1, 1, At, B1); PG8_BAR;
            }
        }
        if constexpr (ALIGN_EPI) { if (wr == 0) PG8_BAR; }
        { int tz = threadIdx.x; asm volatile("" : "+v"(tz));
          const int lz = tz & 63; E(acc, cur, wr, wc, lz & 15, lz >> 4); }
        if (!has_next) break;
#pragma unroll
        for (int a = 0; a < 2; ++a)
#pragma unroll
            for (int b = 0; b < 2; ++b)
#pragma unroll
                for (int m = 0; m < 4; ++m)
#pragma unroll
                    for (int n = 0; n < 2; ++n) acc[a][b][m][n] = (f32x4){0.f, 0.f, 0.f, 0.f};
        cur = nxt; cA = nA; cB = nB; ++ui;
        if constexpr (Sched::GATHER) {
#pragma unroll
            for (int h = 0; h < 2; ++h)
#pragma unroll
                for (int i = 0; i < 2; ++i) cOff[h][i] = nOff[h][i];
        }
        if constexpr (ALIGN_EPI) { if (wr == 1) PG8_BAR; }
    }
    PG8_WAIT_V(0);
    if constexpr (!ALIGN_EPI) { if (wr == 0) PG8_BAR; }
    PG8_BAR;
#undef PG8_SA
#undef PG8_SB
#undef PG8_STAGE
#undef PG8_STAGE_A
#undef PG8_LDA
#undef PG8_LDB
#undef PG8_MMA
#undef PG8_WAIT_V
#undef PG8_WAIT_L
#undef PG8_BAR
#undef PG8_SCHED
}
}

#define XB_TMO      128
#define XB_XCNT(j)  (256  + 64 * (j))
#define XB_XSUB(j)  (1280 + 64 * (j))
#define XB_XGEN(j)  (2304 + 64 * (j))
#define XB_TOP      3328
#define XB_TOPGEN   3392
#define XCD_BAR_WORDS 3456
#define XB_SPIN_CAP (1u << 18)
__device__ __forceinline__ unsigned xb_ld(unsigned* p)              { return __hip_atomic_load(p, __ATOMIC_RELAXED, __HIP_MEMORY_SCOPE_AGENT); }
__device__ __forceinline__ unsigned xb_add(unsigned* p, unsigned v) { return __hip_atomic_fetch_add(p, v, __ATOMIC_RELAXED, __HIP_MEMORY_SCOPE_AGENT); }
__device__ __forceinline__ unsigned xb_xcc_id() { return (unsigned)__builtin_amdgcn_s_getreg((3 << 11) | 20) & 0xFu; }
#define XB_SPIN(cond, bar) do { unsigned _sp = 0; while (cond) { __builtin_amdgcn_s_sleep(1); \
    if ((++_sp & 255u) == 0u) { if (xb_ld(&(bar)[XB_TMO])) break; if (_sp > XB_SPIN_CAP) { atomicAdd(&(bar)[XB_TMO], 1u); break; } } } } while (0)
struct XcdBarrier { unsigned* bar; unsigned x; volatile LAS unsigned* st; };
__device__ __forceinline__ XcdBarrier xcd_barrier_post(unsigned* bar, volatile LAS unsigned* st) {
    XcdBarrier b; b.bar = bar; b.x = xb_xcc_id(); b.st = st;
    if (threadIdx.x == 0) (void)xb_add(&bar[XB_XCNT(b.x)], 1u);
    return b;
}
__device__ __forceinline__ void xcd_barrier_complete(unsigned* bar, unsigned x, unsigned& nloc, unsigned& nx) {
    const unsigned G = gridDim.x * gridDim.y * gridDim.z;
    unsigned sum, cnt, mine, sp = 0u;
    for (;;) {
        sum = 0u; cnt = 0u; mine = 0u;
#pragma unroll
        for (unsigned j = 0; j < 16; ++j) { const unsigned c = xb_ld(&bar[XB_XCNT(j)]); sum += c; cnt += (c > 0u) ? 1u : 0u; mine = (j == x) ? c : mine; }
        if (sum == G) break;
        __builtin_amdgcn_s_sleep(1);
        if ((++sp & 255u) == 0u) { if (xb_ld(&bar[XB_TMO])) break; if (sp > XB_SPIN_CAP) { atomicAdd(&bar[XB_TMO], 1u); break; } }
    }
    nloc = mine > 0u ? mine : 1u; nx = cnt > 0u ? cnt : 1u;
}
__device__ __forceinline__ void xcd_barrier(const XcdBarrier& b) {
    asm volatile("s_waitcnt vmcnt(0)" ::: "memory");
    __syncthreads();
    if (threadIdx.x == 0) {
        unsigned* bar = b.bar;
        __builtin_amdgcn_s_waitcnt(0);
        unsigned nloc = b.st[0], nx = b.st[1];
        if (nloc == 0u) { xcd_barrier_complete(bar, b.x, nloc, nx); b.st[0] = nloc; b.st[1] = nx; }
        const unsigned old = xb_add(&bar[XB_XSUB(b.x)], 1u);
        const unsigned gen = old / nloc;
        if (old + 1u == (gen + 1u) * nloc) {
            __builtin_amdgcn_fence(__ATOMIC_RELEASE, "agent");
            asm volatile("s_waitcnt vmcnt(0)" ::: "memory");
            const unsigned og = xb_add(&bar[XB_TOP], 1u);
            const unsigned tg = og / nx;
            if (og + 1u == (tg + 1u) * nx) xb_add(&bar[XB_TOPGEN], 1u);
            else XB_SPIN(xb_ld(&bar[XB_TOPGEN]) == tg, bar);
            __builtin_amdgcn_fence(__ATOMIC_ACQUIRE, "agent");
            xb_add(&bar[XB_XGEN(b.x)], 1u);
            asm volatile("s_waitcnt vmcnt(0)" ::: "memory");
        } else {
            XB_SPIN(xb_ld(&bar[XB_XGEN(b.x)]) == gen, bar);
            __builtin_amdgcn_fence(__ATOMIC_ACQUIRE, "agent");
            asm volatile("s_waitcnt vmcnt(0)" ::: "memory");
        }
    }
    __syncthreads();
}

using pg8::Unit;
typedef const f32x4 (&AccRef)[2][2][4][2];
DI u32x4 pack8(const f32x4& a, const f32x4& b) { u32x4 w; w.x = cvt_pk_bf16(a[0], a[1]); w.y = cvt_pk_bf16(a[2], a[3]); w.z = cvt_pk_bf16(b[0], b[1]); w.w = cvt_pk_bf16(b[2], b[3]); return w; }

struct EpiStoreBf16 {
    static constexpr bool PERM = true;
    bf16* O; int ldc;
    DI void operator()(AccRef acc, const Unit& u, int wr, int wc, int fr, int fq) const {
        const int row0 = u.pm * 256 + wr * 64 + fr, col0 = u.pn * 256 + wc * 32 + 8 * fq;
#pragma unroll
        for (int ai = 0; ai < 2; ++ai)
#pragma unroll
            for (int m = 0; m < 4; ++m) { bf16* rowp = O + (size_t)(row0 + ai * 128 + m * 16) * ldc + col0;
#pragma unroll
                for (int bj = 0; bj < 2; ++bj) *(u32x4*)(rowp + bj * 128) = pack8(acc[ai][bj][m][0], acc[ai][bj][m][1]); }
    }
};
struct EpiUp {
    static constexpr bool PERM = true;
    bf16* Q; bf16* KN; bf16* VT; const float* ropec; const float* ropes;
    DI void operator()(AccRef acc, const Unit& u, int wr, int wc, int fr, int fq) const {
        const int rl0 = wr * 64 + fr, b = u.pm / 9, s00 = (u.pm % 9) * 256;
        if (u.pn < 3) {
#pragma unroll
            for (int ai = 0; ai < 2; ++ai)
#pragma unroll
                for (int m = 0; m < 4; ++m) { const int rl = rl0 + ai * 128 + m * 16, s = s00 + rl; const size_t row = (size_t)u.pm * 256 + rl;
#pragma unroll
                    for (int bj = 0; bj < 2; ++bj) { const int c0 = u.pn * 256 + bj * 128 + wc * 32 + 8 * fq, w = c0 % 96;
                        f32x4 v0 = acc[ai][bj][m][0] * QSCALE, v1 = acc[ai][bj][m][1] * QSCALE;
                        if (w >= 64 && s >= CTXL) { const int i0 = (w - 64) >> 1; const f32x4 cs = *(const f32x4*)(ropec + (size_t)(s - CTXL) * 16 + i0), sn = *(const f32x4*)(ropes + (size_t)(s - CTXL) * 16 + i0);
                            f32x4 r0, r1;
                            r0[0] = v0[0] * cs[0] - v0[1] * sn[0]; r0[1] = v0[1] * cs[0] + v0[0] * sn[0];
                            r0[2] = v0[2] * cs[1] - v0[3] * sn[1]; r0[3] = v0[3] * cs[1] + v0[2] * sn[1];
                            r1[0] = v1[0] * cs[2] - v1[1] * sn[2]; r1[1] = v1[1] * cs[2] + v1[0] * sn[2];
                            r1[2] = v1[2] * cs[3] - v1[3] * sn[3]; r1[3] = v1[3] * cs[3] + v1[2] * sn[3];
                            v0 = r0; v1 = r1; }
                        *(u32x4*)(Q + row * 768 + c0) = pack8(v0, v1); }
                    asm volatile("" ::: "memory"); }
        } else {
#pragma unroll
            for (int ai = 0; ai < 2; ++ai)
#pragma unroll
                for (int m = 0; m < 4; ++m) { const int rl = rl0 + ai * 128 + m * 16, s = s00 + rl; const size_t row = (size_t)u.pm * 256 + rl;
#pragma unroll
                    for (int bj = 0; bj < 2; ++bj) { const int head = (u.pn - 3) * 2 + bj, within = wc * 32 + 8 * fq;
                        if (wc < 2) *(u32x4*)(KN + row * 512 + head * 64 + within) = pack8(acc[ai][bj][m][0], acc[ai][bj][m][1]);
                        else { bf16* vp = VT + ((size_t)(b * 8 + head) * 64 + (within - 64)) * LT + s;
#pragma unroll
                            for (int n = 0; n < 2; ++n)
#pragma unroll
                                for (int j = 0; j < 4; ++j) vp[(size_t)(4 * n + j) * LT] = (bf16)f2bf(acc[ai][bj][m][n][j]); } }
                    asm volatile("" ::: "memory"); }
        }
    }
};
struct EpiResid {
    static constexpr bool PERM = true;
    bf16* XS; const float* gate;
    DI void operator()(AccRef acc, const Unit& u, int wr, int wc, int fr, int fq) const {
        const int mr = (u.pm % 9 == 0) ? 8 : u.pm / 9;
        const int row0 = u.pm * 256 + wr * 64 + fr, col0 = u.pn * 256 + wc * 32 + 8 * fq;
        f32x4 g[2][2];
#pragma unroll
        for (int bj = 0; bj < 2; ++bj)
#pragma unroll
            for (int n = 0; n < 2; ++n) g[bj][n] = *(const f32x4*)(gate + (size_t)mr * 6144 + col0 + bj * 128 + n * 4);
#pragma unroll
        for (int ai = 0; ai < 2; ++ai)
#pragma unroll
            for (int m = 0; m < 4; ++m) { bf16* rowp = XS + (size_t)(row0 + ai * 128 + m * 16) * D + col0;
#pragma unroll
                for (int bj = 0; bj < 2; ++bj) { u32x4* p = (u32x4*)(rowp + bj * 128); const u32x4 o = *p; f32x4 x0, x1;
                    x0[0] = bf2f(o.x & 0xffffu); x0[1] = bf2f(o.x >> 16); x0[2] = bf2f(o.y & 0xffffu); x0[3] = bf2f(o.y >> 16); x1[0] = bf2f(o.z & 0xffffu); x1[1] = bf2f(o.z >> 16); x1[2] = bf2f(o.w & 0xffffu); x1[3] = bf2f(o.w >> 16);
                    *p = pack8(x0 + g[bj][0] * acc[ai][bj][m][0], x1 + g[bj][1] * acc[ai][bj][m][1]); }
                asm volatile("" ::: "memory"); }
    }
};
struct EpiSwiglu {
    static constexpr bool PERM = true;
    bf16* O; int ldc;
    DI void operator()(AccRef acc, const Unit& u, int wr, int wc, int fr, int fq) const {
        const int row0 = u.pm * 256 + wr * 64 + fr, col0 = u.pn * 128 + wc * 32 + 8 * fq;
#pragma unroll
        for (int ai = 0; ai < 2; ++ai)
#pragma unroll
            for (int m = 0; m < 4; ++m) { f32x4 y[2];
#pragma unroll
                for (int n = 0; n < 2; ++n)
#pragma unroll
                    for (int j = 0; j < 4; ++j) { const float g = acc[ai][0][m][n][j]; y[n][j] = g * __builtin_amdgcn_rcpf(1.f + __expf(-g)) * acc[ai][1][m][n][j]; }
                *(u32x4*)(O + (size_t)(row0 + ai * 128 + m * 16) * ldc + col0) = pack8(y[0], y[1]); }
    }
};
struct EpiOddIn {
    static constexpr bool PERM = true;
    bf16* QKVR; bf16* GATE; float* AB;
    DI void operator()(AccRef acc, const Unit& u, int wr, int wc, int fr, int fq) const {
        const int row0 = u.pm * 256 + wr * 64 + fr, cw = wc * 32 + 8 * fq;
#pragma unroll
        for (int ai = 0; ai < 2; ++ai)
#pragma unroll
            for (int m = 0; m < 4; ++m) { const size_t row = (size_t)(row0 + ai * 128 + m * 16);
                if (u.pn < 12) {
#pragma unroll
                    for (int bj = 0; bj < 2; ++bj) *(u32x4*)(QKVR + row * 3072 + u.pn * 256 + bj * 128 + cw) = pack8(acc[ai][bj][m][0], acc[ai][bj][m][1]);
                } else if (u.pn < 16) {
#pragma unroll
                    for (int bj = 0; bj < 2; ++bj) *(u32x4*)(GATE + row * 1024 + (u.pn - 12) * 256 + bj * 128 + cw) = pack8(acc[ai][bj][m][0], acc[ai][bj][m][1]);
                } else if (wc == 0) {
                    *(f32x4*)(AB + row * 32 + 8 * fq) = acc[ai][0][m][0]; *(f32x4*)(AB + row * 32 + 8 * fq + 4) = acc[ai][0][m][1];
                } }
    }
};
struct EpiMoeDown {
    static constexpr bool PERM = true;
    bf16* YM; const float* GWt;
    DI void operator()(AccRef acc, const Unit& u, int wr, int wc, int fr, int fq) const {
        const int rl0 = wr * 64 + fr, col0 = u.pn * 256 + wc * 32 + 8 * fq;
        const int ex = u.e & 255, r0 = u.e >> 8, cnt = u.cnt;
#pragma unroll
        for (int ai = 0; ai < 2; ++ai)
#pragma unroll
            for (int m = 0; m < 4; ++m) { const int rl = rl0 + ai * 128 + m * 16, p = r0 + rl;
                if (p < cnt) { const float gwv = GWt[(size_t)ex * T + p]; bf16* rowp = YM + ((size_t)u.pm * 256 + rl) * D + col0;
#pragma unroll
                    for (int bj = 0; bj < 2; ++bj) *(u32x4*)(rowp + bj * 128) = pack8(acc[ai][bj][m][0] * gwv, acc[ai][bj][m][1] * gwv); } }
    }
};

template <bool GATHER_> struct MoeOrder {
    static constexpr bool GATHER = GATHER_;
    const bf16* A; const bf16* Bt; int lda, ldb; size_t bexp;
    const int* list; const LAS int* tab;
    int NN, G, c, hi;
    DI bool locate(long L, Unit& u) const {
        int tb = 0; bool found = false;
#pragma unroll
        for (int e = 0; e < NEXP; ++e) { const int ce = tab[e], te = (ce + 255) >> 8; const long ue = (long)te * NN;
            if (!found) { if (L < ue) { found = true; const int mt = GATHER ? (int)((L / 4) % te) : (int)(L / NN), pn = GATHER ? (int)((L / (4 * te)) * 4 + (L % 4)) : (int)(L % NN); u.pm = tb + mt;   u.pn = pn; u.e = ((mt * 256) << 8) | e; u.cnt = ce; u.aux = 0; } else { L -= ue; tb += te; } } }
        return found;
    }
    DI bool next(int i, Unit& u) const { const long L = (long)i * G + c; if (L >= hi) return false; return locate(L, u); }
    DI const char* abase(const Unit& u) const { return GATHER ? (const char*)A : (const char*)A + (size_t)u.pm * 256 * lda * 2; }
    DI const char* bbase(const Unit& u) const { return (const char*)Bt + ((size_t)(u.e & 255) * bexp + (size_t)u.pn * 256 * ldb) * 2; }
    DI unsigned arow(const Unit& u, int r) const { const int p = (u.e >> 8) + r; return (unsigned)list[(size_t)(u.e & 255) * T + p] * (unsigned)(lda * 2); }
};
struct MoeTailOrder {
    static constexpr bool GATHER = false;
    MoeOrder<false> M; int full, R, S, KS;
    DI bool next(int i, Unit& u) const { if (i > 0 || M.c >= R * S) return false; const int ut = M.c / S, ks = M.c % S; const bool ok = M.locate((long)full + ut, u); u.aux = (ut << 8) | ks; return ok; }
    DI const char* abase(const Unit& u) const { return M.abase(u) + (size_t)(u.aux & 255) * KS * 2; }
    DI const char* bbase(const Unit& u) const { return M.bbase(u) + (size_t)(u.aux & 255) * KS * 2; }
    DI unsigned arow(const Unit&, int) const { return 0u; }
};
struct EpiMoeDownPart {
    static constexpr bool PERM = true;
    bf16* PB; const float* GWt;
    DI void operator()(AccRef acc, const Unit& u, int wr, int wc, int fr, int fq) const {
        const int rl0 = wr * 64 + fr, cw = wc * 32 + 8 * fq, ex = u.e & 255, r0 = u.e >> 8, cnt = u.cnt;
        bf16* base = PB + ((size_t)(u.aux & 255) * 128 + (u.aux >> 8)) * 65536;
#pragma unroll
        for (int ai = 0; ai < 2; ++ai)
#pragma unroll
            for (int m = 0; m < 4; ++m) { const int rl = rl0 + ai * 128 + m * 16, p = r0 + rl; const float gwv = p < cnt ? GWt[(size_t)ex * T + p] : 0.f;
#pragma unroll
                for (int bj = 0; bj < 2; ++bj) *(u32x4*)(base + (size_t)rl * 256 + bj * 128 + cw) = pack8(acc[ai][bj][m][0] * gwv, acc[ai][bj][m][1] * gwv); }
    }
};

DI void transpose_item(const float* W, int ldw, bf16* WT, int ldt, int k0, int kd0, int n0, int sc, LAS float* scr, int lane) {
    const int scc = sc < 0 ? 0 : sc; const float msk = sc < 0 ? 0.f : 1.f;
    const float* wp = W + (size_t)(k0 + (lane >> 5)) * ldw + scc;
#pragma unroll 8
    for (int i = 0; i < 32; ++i) scr[(2 * i + (lane >> 5)) * 33 + (lane & 31)] = __builtin_nontemporal_load(wp + (size_t)(2 * i) * ldw) * msk;
    LDS_WAIT(); asm volatile("" ::: "memory");
    const int c = lane & 7;
#pragma unroll
    for (int j = 0; j < 4; ++j) { const int n = (lane >> 3) + 8 * j; const LAS float* s = scr + (8 * c) * 33 + n;
        u32x4 o; o.x = cvt_pk_bf16(s[0 * 33], s[1 * 33]); o.y = cvt_pk_bf16(s[2 * 33], s[3 * 33]); o.z = cvt_pk_bf16(s[4 * 33], s[5 * 33]); o.w = cvt_pk_bf16(s[6 * 33], s[7 * 33]);
        *(u32x4*)(WT + (size_t)(n0 + n) * ldt + kd0 + k0 + 8 * c) = o; }
    LDS_WAIT(); asm volatile("" ::: "memory");
}
DI void conv_job(int& it, int NGW, const float* W, int ldw, int Ksrc, bf16* WT, int ldt, int kd0, int ndst, int mode, int p0, int nsrc, LAS float* scr, int lane) {
    const int nnb = ndst / 32, items = (Ksrc / 64) * nnb;
    for (; it < items; it += NGW) {
        const int kb = it / nnb, nb = it % nnb, n = nb * 32 + (lane & 31);
        int sc;
        if (mode == 0) sc = n < nsrc ? n : -1;
        else if (mode == 1) { const int g = (n >> 7) & 1, p = n >> 8, j = n & 127; sc = g * p0 + 128 * p + j; }
        else { const int h = n / 96, w = n % 96; if (w < 64) sc = n; else { const int idx = w - 64, i = idx >> 1, ab = idx & 1; const int o = ab ? (i < 8 ? 8 + i : 16 + i) : (i < 8 ? i : 8 + i); sc = h * 96 + 64 + o; } }
        transpose_item(W, ldw, WT, ldt, kb * 64, kd0, nb * 32, sc, scr, lane);
    }
    it -= items;
}
struct Args { const float* in[57]; float* out; unsigned char* ws; int ph_lo, ph_hi; };

DI void convert_layer(const Args& a, unsigned char* ws, int layer, LAS unsigned char* lds, int G, int bx) {
    int tid = threadIdx.x; asm volatile("" : "+v"(tid));
    const int lane = tid & 63, wave = __builtin_amdgcn_readfirstlane(tid >> 6), gw = bx * NWAVES + wave, NGW = G * NWAVES, gtid = bx * NTHR + tid, NGT = G * NTHR;
    (void)lane; (void)wave; (void)gw; (void)NGW; (void)gtid; (void)NGT;
    LAS float* scr = (LAS float*)(lds + wave * 8448);
    int it = gw; unsigned char* wb = ws + WS_W;
    if ((layer & 1) == 0) {
        conv_job(it, NGW, a.in[LIN(layer, 3)], EVEN_IN, D, (bf16*)(wb + WE_IN), D, 0, EVEN_INP, 0, 0, EVEN_IN, scr, lane);
        conv_job(it, NGW, a.in[LIN(layer, 6)], 768, 256, (bf16*)(wb + WE_UP), UP_K, 0, 768, 2, 0, 768, scr, lane);
        conv_job(it, NGW, a.in[LIN(layer, 8)], 1024, 128, (bf16*)(wb + WE_UP) + (size_t)768 * UP_K, UP_K, 256, 1024, 0, 0, 1024, scr, lane);
        conv_job(it, NGW, a.in[LIN(layer, 9)], D, D, (bf16*)(wb + WE_OUT), D, 0, D, 0, 0, D, scr, lane);
        conv_job(it, NGW, a.in[LIN(layer, 11)], 2 * FFN_F, D, (bf16*)(wb + WE_W1), D, 0, 2 * FFN_F, 1, FFN_F, 0, scr, lane);
        conv_job(it, NGW, a.in[LIN(layer, 12)], D, FFN_F, (bf16*)(wb + WE_W2), FFN_F, 0, D, 0, 0, D, scr, lane);
        bf16* up = (bf16*)(wb + WE_UP); const u32x4 z = (u32x4){0u, 0u, 0u, 0u};
        for (int i = gtid; i < 768 * 16; i += NGT) *(u32x4*)(up + (size_t)(i >> 4) * UP_K + 256 + (i & 15) * 8) = z;
        for (int i = gtid; i < 1024 * 32; i += NGT) *(u32x4*)(up + (size_t)(768 + (i >> 5)) * UP_K + (i & 31) * 8) = z;
    } else {
        unsigned char* wo = ws + WS_WO;
        conv_job(it, NGW, a.in[LIN(layer, 3)], ODD_IN, D, (bf16*)(wo + WO_IN), D, 0, ODD_INP, 0, 0, ODD_IN, scr, lane);
        conv_job(it, NGW, a.in[LIN(layer, 8)], D, D, (bf16*)(wo + WO_OUT), D, 0, D, 0, 0, D, scr, lane);
    }
}
constexpr int MOE_ITEMS_E = 3584 + 1792, MOE_ITEMS = NEXP * MOE_ITEMS_E, MOE_Q1 = 10752, MOE_Q2 = 39424;
DI void convert_moe(const Args& a, unsigned char* ws, int layer, LAS unsigned char* lds, int w, int nw, int lo, int hi) {
    int tid = threadIdx.x; asm volatile("" : "+v"(tid));
    const int lane = tid & 63, wave = __builtin_amdgcn_readfirstlane(tid >> 6);
    LAS float* scr = (LAS float*)(lds + wave * 8448); unsigned char* wo = ws + WS_WO;
    for (int idx = lo + w; idx < hi; idx += nw) {
        const int e = idx / MOE_ITEMS_E, r = idx % MOE_ITEMS_E;
        if (r < 3584) { const int kb = r / 224, nb = r % 224, n = nb * 32 + (lane & 31); const int g = (n >> 7) & 1, p = n >> 8, j = n & 127;
            transpose_item(a.in[LIN(layer, 11)] + (size_t)e * D * 2 * MOE_F, 2 * MOE_F, (bf16*)(wo + WO_W1) + (size_t)e * 2 * MOE_F * D, D, kb * 64, 0, nb * 32, g * MOE_F + 128 * p + j, scr, lane); }
        else { const int r2 = r - 3584, kb = r2 / 32, nb = r2 % 32;
            transpose_item(a.in[LIN(layer, 12)] + (size_t)e * MOE_F * D, D, (bf16*)(wo + WO_W2) + (size_t)e * D * MOE_F, MOE_F, kb * 64, 0, nb * 32, nb * 32 + (lane & 31), scr, lane); }
    }
}

DI void prologue_mod_partial(const Args& a, unsigned char* ws, LAS unsigned char* lds, int G, int bx) {
    int tid = threadIdx.x; asm volatile("" : "+v"(tid));
    const int lane = tid & 63, wave = __builtin_amdgcn_readfirstlane(tid >> 6), gw = bx * NWAVES + wave, NGW = G * NWAVES, gtid = bx * NTHR + tid, NGT = G * NTHR;
    float* ropec = (float*)(ws + WS_ROPE); float* ropes = ropec + 2048 * 16;
    for (int i = gtid; i < 2048 * 16; i += NGT) { const int pos = i >> 4, j = i & 15; const int rc = j < 8 ? (pos >> 6) : (pos & 63);
        const float inv = exp2f(-(float)(j & 7) * (13.287712379549449f / 8.f)); const float ang = (float)rc * inv; ropec[i] = cosf(ang); ropes[i] = sinf(ang); }
    LAS float* sc = (LAS float*)lds;
    for (int i = tid; i < 9 * 1024; i += NTHR) { const int r = i >> 10, k = i & 1023; const float v = r < 8 ? a.in[IN_C][r * 1024 + k] : a.in[IN_CCTX][k]; sc[k * 12 + r] = silu_f(v); }
    __syncthreads();
    float* part = (float*)(ws + WS_R0);
    for (int it = gw; it < 4 * 24 * 16; it += NGW) { const int layer = it / 384, cg = (it % 384) >> 4, ks = it & 15, n = cg * 256 + 4 * lane;
        const float* mw = a.in[LIN(layer, 0)] + (size_t)(ks * 64) * 6144 + n;
        f32x4 acc[9];
#pragma unroll
        for (int r = 0; r < 9; ++r) acc[r] = (f32x4){0.f, 0.f, 0.f, 0.f};
#pragma unroll 1
        for (int k8 = 0; k8 < 64; k8 += 8) {
        f32x4 wv[8];
#pragma unroll
        for (int k = 0; k < 8; ++k) wv[k] = *(const f32x4*)(mw + (size_t)(k8 + k) * 6144);
#pragma unroll
        for (int kk = 0; kk < 8; ++kk) { const int k = k8 + kk; const f32x4 w = wv[kk]; const LAS float* sp = sc + (ks * 64 + k) * 12; const f32x4 s0 = *(const LAS f32x4*)sp, s1 = *(const LAS f32x4*)(sp + 4); const float s8 = sp[8];
            acc[0] += w * s0[0]; acc[1] += w * s0[1]; acc[2] += w * s0[2]; acc[3] += w * s0[3]; acc[4] += w * s1[0]; acc[5] += w * s1[1]; acc[6] += w * s1[2]; acc[7] += w * s1[3]; acc[8] += w * s8; }
        }
#pragma unroll
        for (int r = 0; r < 9; ++r) *(f32x4*)(part + ((size_t)(ks * 4 + layer) * 9 + r) * 6144 + n) = acc[r]; }
    __syncthreads();
}
DI void prologue_mod_reduce(const Args& a, unsigned char* ws, int G, int bx) {
    int tid = threadIdx.x; asm volatile("" : "+v"(tid));
    const int gtid = bx * NTHR + tid, NGT = G * NTHR; const float* part = (const float*)(ws + WS_R0); float* mod = (float*)(ws + WS_MOD);
    for (int i = gtid; i < 4 * 9 * 1536; i += NGT) { const int layer = i / (9 * 1536), n = (i % 1536) * 4; f32x4 v = *(const f32x4*)(a.in[LIN(layer, 1)] + n);
#pragma unroll
        for (int ks = 0; ks < 16; ++ks) v = v + *(const f32x4*)(part + (size_t)ks * 4 * 9 * 6144 + (size_t)(i / 1536) * 6144 + n);
        *(f32x4*)(mod + (size_t)(i / 1536) * 6144 + n) = v; }
}

DI void norm_phase(const Args& a, unsigned char* ws, int layer, int which, int G, int bx) {
    int tid = threadIdx.x; asm volatile("" : "+v"(tid));
    const int lane = tid & 63, wave = __builtin_amdgcn_readfirstlane(tid >> 6), gw = bx * NWAVES + wave, NGW = G * NWAVES, gtid = bx * NTHR + tid, NGT = G * NTHR;
    (void)lane; (void)wave; (void)gw; (void)NGW; (void)gtid; (void)NGT;
    bf16* XS = (bf16*)(ws + WS_XS); bf16* H = (bf16*)(ws + WS_H);
    const bool from_in = (layer == 0 && which == 0), combine = (which == 2) || (which == 0 && layer > 0 && ((layer - 1) & 1));
    const int lprev = which == 2 ? 3 : layer - 1;
    const float* gvec = which == 2 ? a.in[IN_FINAL] : a.in[LIN(layer, which == 0 ? 2 : ((layer & 1) ? 9 : 10))];
    const float* mod = (float*)(ws + WS_MOD) + (size_t)(which == 2 ? 0 : layer) * 9 * 6144;
    const float* modp = (float*)(ws + WS_MOD) + (size_t)(lprev < 0 ? 0 : lprev) * 9 * 6144;
    const bool route = (which == 1) && (layer & 1);
    int tb[NEXP]; int tailL = 0x7fffffff, tailS = 1;
    if (combine) { const unsigned* cw = (const unsigned*)(ws + WS_CTL) + CW_CNT + (lprev >> 1) * 8 * 64; int acc = 0;
#pragma unroll
        for (int e = 0; e < NEXP; ++e) { tb[e] = acc; acc += ((int)__hip_atomic_load(cw + e * 64, __ATOMIC_RELAXED, __HIP_MEMORY_SCOPE_AGENT) + 255) >> 8; }
        const int U = acc * 4, full = (U / G) * G, R = U - full; tailS = (R == 0) ? 1 : (4 * R <= G ? 4 : (2 * R <= G ? 2 : 1)); if (tailS > 1) tailL = full; }
    const bf16* const PBp = (const bf16*)(ws + WS_END);
    f32x4 gv[4];
#pragma unroll
    for (int j = 0; j < 4; ++j) gv[j] = *(const f32x4*)(gvec + 4 * lane + 256 * j);
    f32x4 rw[16][2];
    if (route) { const float* rwp = a.in[LIN(layer, 10)];
#pragma unroll
        for (int j = 0; j < 4; ++j)
#pragma unroll
            for (int i = 0; i < 4; ++i) { const int k = 4 * lane + 256 * j + i; rw[4 * j + i][0] = *(const f32x4*)(rwp + (size_t)k * 8); rw[4 * j + i][1] = *(const f32x4*)(rwp + (size_t)k * 8 + 4); } }
    int kq = 0, pe0 = 0, pe1 = 0, pt = 0; float pw0 = 0.f;
    const int CHK_ = route ? (T + NGW - 1) / NGW : 0;
    u32x2 nrow[4];
#pragma unroll
    for (int j = 0; j < 4; ++j) nrow[j] = (u32x2){0u, 0u};
    { const int t0_ = route ? gw * CHK_ : gw; if (!from_in && t0_ < T) {
#pragma unroll
        for (int j = 0; j < 4; ++j) nrow[j] = *(const u32x2*)(XS + (size_t)t0_ * D + 4 * lane + 256 * j); } }
    for (int it_ = 0;; ++it_) {
        const int t = route ? gw * CHK_ + it_ : gw + it_ * NGW;
        if (t >= T || (route && it_ >= CHK_)) break;
        u32x2 crow[4];
#pragma unroll
        for (int j = 0; j < 4; ++j) crow[j] = nrow[j];
        { const int tn = route ? t + 1 : t + NGW; if (!from_in && tn < T) {
#pragma unroll
            for (int j = 0; j < 4; ++j) nrow[j] = *(const u32x2*)(XS + (size_t)tn * D + 4 * lane + 256 * j); } }
        const int b = t / LT, s = t % LT, mr = s < CTXL ? 8 : b;
        if ((which == 2 || (which == 1 && layer == 3)) && s < CTXL) continue;
        f32x4 v[4];
        if (from_in) { const float* src = s < CTXL ? a.in[IN_CTX] + ((size_t)b * CTXL + s) * D : a.in[IN_X] + ((size_t)b * SEQ + (s - CTXL)) * D;
#pragma unroll
            for (int j = 0; j < 4; ++j) v[j] = *(const f32x4*)(src + 4 * lane + 256 * j);
        } else {
#pragma unroll
            for (int j = 0; j < 4; ++j) { const u32x2 p = crow[j]; v[j][0] = bf2f(p.x & 0xffffu); v[j][1] = bf2f(p.x >> 16); v[j][2] = bf2f(p.y & 0xffffu); v[j][3] = bf2f(p.y >> 16); }
        }
        if (combine) {
            const int4 tk = *(const int4*)(ws + WS_TOK + (size_t)t * 16);
            int t0 = 0, t1 = 0;
#pragma unroll
            for (int e = 0; e < NEXP; ++e) { t0 = tk.x == e ? tb[e] : t0; t1 = tk.z == e ? tb[e] : t1; }
            const int row0 = __builtin_amdgcn_readfirstlane(t0 * 256 + tk.y), row1 = __builtin_amdgcn_readfirstlane(t1 * 256 + tk.w);
            const bf16* ym = (const bf16*)(ws + WS_R1);
            u32x2 q0[4], q1[4];
#pragma unroll
            for (int j = 0; j < 4; ++j) { const int L0 = (row0 >> 8) * 4 + j, L1 = (row1 >> 8) * 4 + j;
                const bf16* a0 = L0 >= tailL ? PBp + ((size_t)(L0 - tailL) * 256 + (row0 & 255)) * 256 : ym + (size_t)row0 * D + 256 * j;
                const bf16* a1 = L1 >= tailL ? PBp + ((size_t)(L1 - tailL) * 256 + (row1 & 255)) * 256 : ym + (size_t)row1 * D + 256 * j;
                q0[j] = *(const u32x2*)(a0 + 4 * lane); q1[j] = *(const u32x2*)(a1 + 4 * lane); }
            f32x4 y[4];
#pragma unroll
            for (int j = 0; j < 4; ++j) { y[j][0] = bf2f(q0[j].x & 0xffffu) + bf2f(q1[j].x & 0xffffu); y[j][1] = bf2f(q0[j].x >> 16) + bf2f(q1[j].x >> 16); y[j][2] = bf2f(q0[j].y & 0xffffu) + bf2f(q1[j].y & 0xffffu); y[j][3] = bf2f(q0[j].y >> 16) + bf2f(q1[j].y >> 16); }
            if ((row0 >> 8) * 4 + 3 >= tailL || (row1 >> 8) * 4 + 3 >= tailL) {
#pragma unroll
                for (int j = 0; j < 4; ++j)
#pragma unroll
                    for (int sl = 0; sl < 2; ++sl) { const int row = sl ? row1 : row0, L = (row >> 8) * 4 + j;
                        if (L >= tailL) { const bf16* pp = PBp + ((size_t)(L - tailL) * 256 + (row & 255)) * 256 + 4 * lane;
                            for (int ks = 1; ks < tailS; ++ks) { const u32x2 p = *(const u32x2*)(pp + (size_t)ks * 128 * 65536); y[j][0] += bf2f(p.x & 0xffffu); y[j][1] += bf2f(p.x >> 16); y[j][2] += bf2f(p.y & 0xffffu); y[j][3] += bf2f(p.y >> 16); } } }
            }
#pragma unroll
            for (int j = 0; j < 4; ++j) { const f32x4 g2 = *(const f32x4*)(modp + (size_t)mr * 6144 + 5 * 1024 + 4 * lane + 256 * j); v[j] = v[j] + g2 * y[j]; }
        }
        if ((from_in || combine) && which != 2) {
#pragma unroll
            for (int j = 0; j < 4; ++j) { u32x2 o; o.x = cvt_pk_bf16(v[j][0], v[j][1]); o.y = cvt_pk_bf16(v[j][2], v[j][3]); *(u32x2*)(XS + (size_t)t * D + 4 * lane + 256 * j) = o;
                v[j][0] = bf2f(o.x & 0xffffu); v[j][1] = bf2f(o.x >> 16); v[j][2] = bf2f(o.y & 0xffffu); v[j][3] = bf2f(o.y >> 16); }
        }
        float ss = 0.f;
#pragma unroll
        for (int j = 0; j < 4; ++j) ss += (v[j][0] * v[j][0] + v[j][1] * v[j][1]) + (v[j][2] * v[j][2] + v[j][3] * v[j][3]);
        const float rstd = rsqrtf(wave_sum(ss) * (1.f / D) + NORM_EPS);
        if (which == 2) {
            float* op = a.out + ((size_t)b * SEQ + (s - CTXL)) * D;
#pragma unroll
            for (int j = 0; j < 4; ++j) *(f32x4*)(op + 4 * lane + 256 * j) = v[j] * rstd * gv[j];
            continue;
        }
        const float* sh = mod + (size_t)mr * 6144 + (which == 0 ? 0 : 3 * 1024), *scp = sh + 1024;
        f32x4 hv[4];
#pragma unroll
        for (int j = 0; j < 4; ++j) { const f32x4 shv = *(const f32x4*)(sh + 4 * lane + 256 * j), scv = *(const f32x4*)(scp + 4 * lane + 256 * j);
            hv[j] = (v[j] * rstd * gv[j]) * (scv + 1.f) + shv;
            u32x2 o; o.x = cvt_pk_bf16(hv[j][0], hv[j][1]); o.y = cvt_pk_bf16(hv[j][2], hv[j][3]);
            *(u32x2*)(H + (size_t)t * D + 4 * lane + 256 * j) = o; }
        if (route) {
            float lg[NEXP];
#pragma unroll
            for (int e = 0; e < NEXP; ++e) lg[e] = 0.f;
#pragma unroll
            for (int j = 0; j < 4; ++j)
#pragma unroll
                for (int i = 0; i < 4; ++i) { const float hx = hv[j][i];
#pragma unroll
                    for (int e = 0; e < 4; ++e) { lg[e] += hx * rw[4 * j + i][0][e]; lg[4 + e] += hx * rw[4 * j + i][1][e]; } }
#pragma unroll
            for (int e = 0; e < NEXP; ++e) lg[e] = wave_sum(lg[e]);
            {
                int e0 = 0; float v0 = lg[0];
#pragma unroll
                for (int e = 1; e < NEXP; ++e) if (lg[e] > v0) { v0 = lg[e]; e0 = e; }
                int e1 = -1; float v1 = -3.0e38f;
#pragma unroll
                for (int e = 0; e < NEXP; ++e) if (e != e0 && lg[e] > v1) { v1 = lg[e]; e1 = e; }
                const float w0 = 1.f / (1.f + __expf(v1 - v0));
                if (lane == kq) { pe0 = e0; pe1 = e1; pw0 = w0; pt = t; }
                ++kq;
            }
        }
    }
    if (route) {
        const int lp_ = layer >> 1; unsigned* ctl = (unsigned*)(ws + WS_CTL);
        if (lane < kq) *(int4*)(ws + WS_TOK + (size_t)pt * 16) = make_int4(pe0, pe1, (int)__float_as_uint(pw0), 1);
        unsigned mycnt = 0;
#pragma unroll
        for (int e = 0; e < NEXP; ++e) { const unsigned long long m = __ballot(lane < kq && (pe0 == e || pe1 == e)); if (lane == e) mycnt = (unsigned)__popcll(m); }
        if (lane < NEXP) { ctl[CW_WCNT + lp_ * 16384 + gw * 8 + lane] = mycnt; __hip_atomic_fetch_add(ctl + CW_WGSUM + lp_ * 2048 + bx * 8 + lane, mycnt, __ATOMIC_RELAXED, __HIP_MEMORY_SCOPE_AGENT); }
    }
}

DI void route_assign_phase(unsigned char* ws, int layer, int G, int bx) {
    int tid = threadIdx.x; asm volatile("" : "+v"(tid));
    const int lane = tid & 63, wave = __builtin_amdgcn_readfirstlane(tid >> 6), gw = bx * NWAVES + wave, NGW = G * NWAVES, lp_ = layer >> 1;
    const unsigned* ctl = (const unsigned*)(ws + WS_CTL); const unsigned* wgs = ctl + CW_WGSUM + lp_ * 2048; const unsigned* wcn = ctl + CW_WCNT + lp_ * 16384;
    unsigned base[NEXP];
#pragma unroll
    for (int e = 0; e < NEXP; ++e) base[e] = 0u;
    for (int w = lane; w < bx; w += 64) {
#pragma unroll
        for (int e = 0; e < NEXP; ++e) base[e] += __hip_atomic_load(wgs + w * 8 + e, __ATOMIC_RELAXED, __HIP_MEMORY_SCOPE_AGENT); }
    if (lane < wave) {
#pragma unroll
        for (int e = 0; e < NEXP; ++e) base[e] += __hip_atomic_load(wcn + (bx * NWAVES + lane) * 8 + e, __ATOMIC_RELAXED, __HIP_MEMORY_SCOPE_AGENT); }
#pragma unroll
    for (int e = 0; e < NEXP; ++e) {
        base[e] = wave_sum_u(base[e]); }
    const int CH = (T + NGW - 1) / NGW, t = gw * CH + lane; const int s_ = t % LT;
    const bool valid = lane < CH && t < T && !(layer == 3 && s_ < CTXL);
    int4 tk = make_int4(0, 0, 0, 0); if (valid) tk = *(const int4*)(ws + WS_TOK + (size_t)t * 16);
    const int e0 = valid ? tk.x : -1, e1 = valid ? tk.y : -1; int p0 = 0, p1 = 0; unsigned tot = 0;
    const unsigned long long ltm = (lane == 0) ? 0ull : (~0ull >> (64 - lane));
#pragma unroll
    for (int e = 0; e < NEXP; ++e) { const unsigned long long m = __ballot(e0 == e || e1 == e); const int rank = __popcll(m & ltm);
        if (e0 == e) p0 = (int)base[e] + rank; if (e1 == e) p1 = (int)base[e] + rank; if (lane == e) tot = base[e] + (unsigned)__popcll(m); }
    if (valid) { const float w0 = __uint_as_float((unsigned)tk.z); int* list = (int*)(ws + WS_LIST); float* gwt = (float*)(ws + WS_GW);
        list[(size_t)e0 * T + p0] = t; gwt[(size_t)e0 * T + p0] = w0; list[(size_t)e1 * T + p1] = t; gwt[(size_t)e1 * T + p1] = 1.f - w0;
        *(int4*)(ws + WS_TOK + (size_t)t * 16) = make_int4(e0, p0, e1, p1); }
    if (gw == NGW - 1 && lane < NEXP) ((unsigned*)(ws + WS_CTL))[CW_CNT + (lp_ * 8 + lane) * 64] = tot;
    if (gw == NGW - 1) {
        int* list = (int*)(ws + WS_LIST);
#pragma unroll
        for (int e = 0; e < NEXP; ++e) { const int c = (int)__shfl(tot, e); for (int p = c + lane; p < ((c + 255) & ~255); p += 64) list[(size_t)e * T + p] = 0; } }
}

DI void unpack8(const u32x4& p, float (&f)[8]) { f[0] = bf2f(p.x & 0xffffu); f[1] = bf2f(p.x >> 16); f[2] = bf2f(p.y & 0xffffu); f[3] = bf2f(p.y >> 16); f[4] = bf2f(p.z & 0xffffu); f[5] = bf2f(p.z >> 16); f[6] = bf2f(p.w & 0xffffu); f[7] = bf2f(p.w >> 16); }
DI void even_mid_phase(const Args& a, unsigned char* ws, int layer, int G, int bx) {
    int tid = threadIdx.x; asm volatile("" : "+v"(tid));
    const int lane = tid & 63, wave = __builtin_amdgcn_readfirstlane(tid >> 6), gw = bx * NWAVES + wave, NGW = G * NWAVES, gtid = bx * NTHR + tid, NGT = G * NTHR;
    (void)lane; (void)wave; (void)gw; (void)NGW; (void)gtid; (void)NGT;
    const bf16* P = (const bf16*)(ws + WS_R0 + RE_P); bf16* MIX = (bf16*)(ws + WS_R0 + RE_MIX); bf16* A2 = (bf16*)(ws + WS_R0 + RE_A2); bf16* KR = (bf16*)(ws + WS_KR);
    const float* ropec = (const float*)(ws + WS_ROPE); const float* ropes = ropec + 2048 * 16;
    const float* cw = a.in[LIN(layer, 4)]; const float* qg = a.in[LIN(layer, 5)]; const float* kg = a.in[LIN(layer, 7)];
    float w0[8], w1[8], w2[8];
#pragma unroll
    for (int i = 0; i < 8; ++i) { w0[i] = cw[8 * lane + i]; w1[i] = cw[512 + 8 * lane + i]; w2[i] = cw[1024 + 8 * lane + i]; }
    const f32x4 qgv = *(const f32x4*)(qg + 4 * lane); const f32x2 kgv = *(const f32x2*)(kg + 2 * lane);
    struct Row { u32x4 gb, x0, x1; u32x2 cq; unsigned ckv; unsigned short ka, kb; float rc, rsn; };
    const int li = lane & 15, oa = li < 8 ? li : 8 + li, ob = li < 8 ? 8 + li : 16 + li;
#define EM_LOAD(dst, tt) do { const int t_ = (tt) < 0 ? 0 : ((tt) > T - 1 ? T - 1 : (tt)); const bf16* p_ = P + (size_t)t_ * EVEN_INP; const int s_ = t_ % LT, sr_ = s_ >= CTXL ? s_ - CTXL : 0; \
        dst.gb = *(const u32x4*)(p_ + 8 * lane); dst.x0 = *(const u32x4*)(p_ + 512 + 8 * lane); dst.x1 = *(const u32x4*)(p_ + 1024 + 8 * lane); dst.cq = *(const u32x2*)(p_ + 1536 + 4 * lane); \
        dst.ckv = *(const unsigned*)(p_ + 1792 + 2 * lane); dst.ka = *(const unsigned short*)(p_ + 1920 + oa); dst.kb = *(const unsigned short*)(p_ + 1920 + ob); \
        dst.rc = ropec[(size_t)sr_ * 16 + li]; dst.rsn = ropes[(size_t)sr_ * 16 + li]; } while (0)
    const int CH = (T + NGW - 1) / NGW, tA = gw * CH, tE = (tA + CH < T) ? tA + CH : T;
    Row r0, r1, r2; float pm[8];
#pragma unroll
    for (int i = 0; i < 8; ++i) pm[i] = 0.f;
    if (tA < tE) { Row rm; EM_LOAD(rm, tA - 1); EM_LOAD(r0, tA); EM_LOAD(r1, tA + 1); float a0[8], a1[8]; unpack8(rm.x0, a0); unpack8(rm.x1, a1);
#pragma unroll
        for (int i = 0; i < 8; ++i) pm[i] = a0[i] * a1[i]; }
#pragma unroll 1
    for (int t = tA; t < tE; ++t) {
        const int s = t % LT; const bool hp = (s != 0 && s != CTXL), hn = (s != CTXL - 1 && s != LT - 1);
        EM_LOAD(r2, t + 2);
        float gb[8], x0[8], x1[8], y[8], p0[8];
        unpack8(r0.gb, gb); unpack8(r0.x0, x0); unpack8(r0.x1, x1);
#pragma unroll
        for (int i = 0; i < 8; ++i) { p0[i] = x0[i] * x1[i]; y[i] = w1[i] * p0[i]; }
        if (hp) {
#pragma unroll
            for (int i = 0; i < 8; ++i) y[i] += w0[i] * pm[i]; }
        unpack8(r1.x0, x0); unpack8(r1.x1, x1);
        if (hn) {
#pragma unroll
            for (int i = 0; i < 8; ++i) y[i] += w2[i] * (x0[i] * x1[i]); }
        { u32x4 o; o.x = cvt_pk_bf16(gb[0] * y[0], gb[1] * y[1]); o.y = cvt_pk_bf16(gb[2] * y[2], gb[3] * y[3]); o.z = cvt_pk_bf16(gb[4] * y[4], gb[5] * y[5]); o.w = cvt_pk_bf16(gb[6] * y[6], gb[7] * y[7]);
          *(u32x4*)(MIX + (size_t)t * D + 8 * lane) = o; }
        { const u32x2 p = r0.cq; const float c0 = bf2f(p.x & 0xffffu), c1 = bf2f(p.x >> 16), c2 = bf2f(p.y & 0xffffu), c3 = bf2f(p.y >> 16);
          const float rs = rsqrtf(wave_sum((c0 * c0 + c1 * c1) + (c2 * c2 + c3 * c3)) * (1.f / 256.f) + NORM_EPS);
          u32x2 o; o.x = cvt_pk_bf16(c0 * rs * qgv[0], c1 * rs * qgv[1]); o.y = cvt_pk_bf16(c2 * rs * qgv[2], c3 * rs * qgv[3]); *(u32x2*)(A2 + (size_t)t * UP_K + 4 * lane) = o; }
        { const unsigned p = r0.ckv; const float c0 = bf2f(p & 0xffffu), c1 = bf2f(p >> 16);
          const float rs = rsqrtf(wave_sum(c0 * c0 + c1 * c1) * (1.f / 128.f) + NORM_EPS);
          *(unsigned*)(A2 + (size_t)t * UP_K + 256 + 2 * lane) = cvt_pk_bf16(c0 * rs * kgv[0], c1 * rs * kgv[1]); }
        if (lane < 16) { const float av = bf2f((unsigned)r0.ka), bv = bf2f((unsigned)r0.kb); float ra = av, rb = bv;
            if (s >= CTXL) { ra = av * r0.rc - bv * r0.rsn; rb = bv * r0.rc + av * r0.rsn; }
            *(unsigned*)(KR + (size_t)t * 32 + 2 * lane) = cvt_pk_bf16(ra, rb); }
#pragma unroll
        for (int i = 0; i < 8; ++i) pm[i] = p0[i];
        r0 = r1; r1 = r2;
    }
#undef EM_LOAD
}

DI void odd_mid_phase(const Args& a, unsigned char* ws, int layer, LAS unsigned char* lds, int G, int bx) {
    int tid = threadIdx.x; asm volatile("" : "+v"(tid));
    const int lane = tid & 63, wave = __builtin_amdgcn_readfirstlane(tid >> 6), gw = bx * NWAVES + wave, NGW = G * NWAVES, gtid = bx * NTHR + tid, NGT = G * NTHR;
    (void)lane; (void)wave; (void)gw; (void)NGW; (void)gtid; (void)NGT;
    const bf16* QR = (const bf16*)(ws + WS_R0); bf16* QN = (bf16*)(ws + WS_R1); const float* AB = (const float*)(ws + WS_AB); float* GB = (float*)(ws + WS_GB);
    LAS float* cwl = (LAS float*)lds;
    { const float* cw = a.in[LIN(layer, 4)]; for (int i = tid; i < 3 * 3072; i += NTHR) cwl[i] = cw[i]; }
    __syncthreads();
    const float* alog = a.in[LIN(layer, 5)]; const float* dtb = a.in[LIN(layer, 6)];
    float Aexp = 0.f, dtv = 0.f; if (lane < 16) { Aexp = __expf(alog[lane]); dtv = dtb[lane]; }
    const int CH = (T + NGW - 1) / NGW, tA = gw * CH, tE = (tA + CH < T) ? tA + CH : T;
    u32x4 rm[6], r0[6], rp[6], rq[6]; float abv = 0.f, abt = 0.f, abvn = 0.f, abtn = 0.f;
#define OM_LOAD(dst, tt) do { const int t_ = (tt) < 0 ? 0 : ((tt) > T - 1 ? T - 1 : (tt)); const bf16* p_ = QR + (size_t)t_ * 3072 + 8 * lane; _Pragma("unroll") for (int g = 0; g < 6; ++g) dst[g] = *(const u32x4*)(p_ + 512 * g); } while (0)
    if (tA < tE) { OM_LOAD(rm, tA - 1); OM_LOAD(r0, tA); OM_LOAD(rp, tA + 1); if (lane < 16) { abv = AB[(size_t)tA * 32 + lane]; abt = AB[(size_t)tA * 32 + 16 + lane]; } }
#pragma unroll 1
    for (int t = tA; t < tE; ++t) {
        const int s = t % LT; const bool hp = (s != 0 && s != CTXL), hn = (s != CTXL - 1 && s != LT - 1);
        OM_LOAD(rq, t + 2);
        if (lane < 16) { const int tn = t + 1 < T ? t + 1 : t; abvn = AB[(size_t)tn * 32 + lane]; abtn = AB[(size_t)tn * 32 + 16 + lane]; }
        const float mp = hp ? 1.f : 0.f, mn = hn ? 1.f : 0.f;
        int lz_ = lane; asm volatile("" : "+v"(lz_));
#pragma unroll
        for (int g = 0; g < 6; ++g) { const int c = 8 * lz_ + 512 * g; float xm[8], x0[8], xp[8], val[8];
            unpack8(rm[g], xm); unpack8(r0[g], x0); unpack8(rp[g], xp);
            const f32x4 wa0 = *(const LAS f32x4*)(cwl + c), wa1 = *(const LAS f32x4*)(cwl + c + 4), wb0 = *(const LAS f32x4*)(cwl + 3072 + c), wb1 = *(const LAS f32x4*)(cwl + 3072 + c + 4), wc0 = *(const LAS f32x4*)(cwl + 6144 + c), wc1 = *(const LAS f32x4*)(cwl + 6144 + c + 4);
#pragma unroll
            for (int i = 0; i < 8; ++i) { const float wA = i < 4 ? wa0[i & 3] : wa1[i & 3], wB = i < 4 ? wb0[i & 3] : wb1[i & 3], wC = i < 4 ? wc0[i & 3] : wc1[i & 3];
                const float y = wA * xm[i] * mp + wB * x0[i] + wC * xp[i] * mn; val[i] = silu_f(y); }
            if (g < 4) { float ss = 0.f;
#pragma unroll
                for (int i = 0; i < 8; ++i) ss += val[i] * val[i];
                ss = sum16(ss);
                const float rs = rsqrtf(ss + NORM_EPS) * (g < 2 ? 0.08838834764831845f : 1.f);
#pragma unroll
                for (int i = 0; i < 8; ++i) val[i] *= rs; }
            u32x4 o; o.x = cvt_pk_bf16(val[0], val[1]); o.y = cvt_pk_bf16(val[2], val[3]); o.z = cvt_pk_bf16(val[4], val[5]); o.w = cvt_pk_bf16(val[6], val[7]);
            *(u32x4*)(QN + (size_t)t * 3072 + 8 * lane + 512 * g) = o; }
        if (lane < 16) { const float z = abv + dtv;
            const float sp = z > 20.f ? z : log1pf(__expf(z));
            GB[(size_t)t * 32 + lane] = -Aexp * sp; GB[(size_t)t * 32 + 16 + lane] = 1.f / (1.f + __expf(-abt)); }
#pragma unroll
        for (int g = 0; g < 6; ++g) { rm[g] = r0[g]; r0[g] = rp[g]; rp[g] = rq[g]; }
        abv = abvn; abt = abtn;
    }
#undef OM_LOAD
    __syncthreads();
}

DI void odd_post_phase(const Args& a, unsigned char* ws, int layer, int G, int bx) {
    int tid = threadIdx.x; asm volatile("" : "+v"(tid));
    const int lane = tid & 63, wave = __builtin_amdgcn_readfirstlane(tid >> 6), gw = bx * NWAVES + wave, NGW = G * NWAVES, gtid = bx * NTHR + tid, NGT = G * NTHR;
    (void)lane; (void)wave; (void)gw; (void)NGW; (void)gtid; (void)NGT;
    const bf16* OF = (const bf16*)(ws + WS_R1); const bf16* OB = OF + (size_t)T * D; bf16* Y = (bf16*)(ws + WS_R1) + (size_t)2 * T * D; const bf16* GATE = (const bf16*)(ws + WS_R2);
    const float* og = a.in[LIN(layer, 7)];
    float gg[16];
#pragma unroll
    for (int i = 0; i < 16; ++i) gg[i] = og[(16 * lane + i) & 127];
    u32x4 nf0, nf1, nb0, nb1, ng0, ng1;
#define OP_LOAD(tt) do { const size_t o_ = (size_t)(tt) * D + 16 * lane; nf0 = *(const u32x4*)(OF + o_); nf1 = *(const u32x4*)(OF + o_ + 8); nb0 = *(const u32x4*)(OB + o_); nb1 = *(const u32x4*)(OB + o_ + 8); \
        ng0 = *(const u32x4*)(GATE + o_); ng1 = *(const u32x4*)(GATE + o_ + 8); } while (0)
    if (gw < T) OP_LOAD(gw);
#pragma unroll 1
    for (int t = gw; t < T; t += NGW) {
        const size_t off = (size_t)t * D + 16 * lane; float o[16], f0[8], f1[8];
        const u32x4 cf0 = nf0, cf1 = nf1, cb0 = nb0, cb1 = nb1, cg0 = ng0, cg1 = ng1;
        if (t + NGW < T) OP_LOAD(t + NGW);
        unpack8(cf0, f0); unpack8(cb0, f1);
#pragma unroll
        for (int i = 0; i < 8; ++i) o[i] = f0[i] + f1[i];
        unpack8(cf1, f0); unpack8(cb1, f1);
#pragma unroll
        for (int i = 0; i < 8; ++i) o[8 + i] = f0[i] + f1[i];
        float ss = 0.f;
#pragma unroll
        for (int i = 0; i < 16; ++i) ss += o[i] * o[i];
        ss = sum8(ss);
        const float rs = rsqrtf(ss * (1.f / 128.f) + NORM_EPS);
        unpack8(cg0, f0); unpack8(cg1, f1);
        float y[16];
#pragma unroll
        for (int i = 0; i < 8; ++i) { y[i] = o[i] * rs * gg[i] * silu_f(f0[i]); y[8 + i] = o[8 + i] * rs * gg[8 + i] * silu_f(f1[i]); }
        u32x4 q0, q1; q0.x = cvt_pk_bf16(y[0], y[1]); q0.y = cvt_pk_bf16(y[2], y[3]); q0.z = cvt_pk_bf16(y[4], y[5]); q0.w = cvt_pk_bf16(y[6], y[7]);
        q1.x = cvt_pk_bf16(y[8], y[9]); q1.y = cvt_pk_bf16(y[10], y[11]); q1.z = cvt_pk_bf16(y[12], y[13]); q1.w = cvt_pk_bf16(y[14], y[15]);
        *(u32x4*)(Y + off) = q0; *(u32x4*)(Y + off + 8) = q1;
    }
#undef OP_LOAD
}

constexpr int AT_KSTR = 208, AT_VSTR = 272, AT_KBYTES = 128 * AT_KSTR, AT_VBYTES = 64 * AT_VSTR, AT_BUF = AT_KBYTES + AT_VBYTES;
DI bf16x8 pack_frag(const f32x4& lo, const f32x4& hi) { u32x4 w = pack8(lo, hi); return __builtin_bit_cast(bf16x8, w); }
DI void attn_phase(unsigned char* ws, LAS unsigned char* lds, int G, int bx) {
    int tid = threadIdx.x; asm volatile("" : "+v"(tid));
    const int lane = tid & 63, wave = __builtin_amdgcn_readfirstlane(tid >> 6);
    const bf16* Q = (const bf16*)(ws + WS_R0 + RE_Q); const bf16* KN = (const bf16*)(ws + WS_R0 + RE_KN); const bf16* VT = (const bf16*)(ws + WS_R0 + RE_VT); const bf16* KR = (const bf16*)(ws + WS_KR);
    bf16* MIX = (bf16*)(ws + WS_R0 + RE_MIX);
    const int fr = lane & 15, fq = lane >> 4;
    const int vcu = (G % 8 == 0) ? (bx & 7) * (G >> 3) + (bx >> 3) : bx;
    for (int L = vcu; L < 576; L += G) {
        int b, h, q0, nk;
        if (L < 512) { b = L >> 6; h = (L >> 3) & 7; q0 = CTXL + (L & 7) * 256; nk = LT; } else { const int r = L - 512; b = r >> 3; h = r & 7; q0 = 0; nk = CTXL; }
        const int ntile = nk / 128; const size_t tb = (size_t)b * LT;
        bf16x8 qf[2][3];
#pragma unroll
        for (int qb = 0; qb < 2; ++qb)
#pragma unroll
            for (int ks = 0; ks < 3; ++ks) qf[qb][ks] = *(const bf16x8*)(Q + (tb + q0 + wave * 32 + qb * 16 + fr) * 768 + h * 96 + ks * 32 + fq * 8);
        f32x4 ot[4][2];
#pragma unroll
        for (int d = 0; d < 4; ++d)
#pragma unroll
            for (int qb = 0; qb < 2; ++qb) ot[d][qb] = (f32x4){0.f, 0.f, 0.f, 0.f};
        float mrow[2] = {0.f, 0.f}, lrow[2] = {0.f, 0.f};
        const int krow = tid >> 3, kch = tid & 7, rrow = tid >> 2, rch = tid & 3, vrow = tid >> 4, vch = tid & 15;
        const bf16* kn_p = KN + (tb + krow) * 512 + h * 64 + kch * 8; const bf16* kr_p = KR + (tb + rrow) * 32 + rch * 8; const bf16* vt_p = VT + ((size_t)(b * 8 + h) * 64 + vrow) * LT + vch * 8;
        u32x4 sk0, sk1, sr, sv0, sv1;
#define AT_LOAD(t_) do { const size_t ko_ = (size_t)(t_) * 128; sk0 = *(const u32x4*)(kn_p + ko_ * 512); sk1 = *(const u32x4*)(kn_p + (ko_ + 64) * 512); sr = *(const u32x4*)(kr_p + ko_ * 32); \
        sv0 = *(const u32x4*)(vt_p + ko_); sv1 = *(const u32x4*)(vt_p + (size_t)32 * LT + ko_); } while (0)
#define AT_WRITE(bb_) do { LAS unsigned char* b2_ = (bb_); *(LAS u32x4*)(b2_ + krow * AT_KSTR + kch * 16) = sk0; *(LAS u32x4*)(b2_ + (krow + 64) * AT_KSTR + kch * 16) = sk1; *(LAS u32x4*)(b2_ + rrow * AT_KSTR + 128 + rch * 16) = sr; \
        *(LAS u32x4*)(b2_ + AT_KBYTES + vrow * AT_VSTR + vch * 16) = sv0; *(LAS u32x4*)(b2_ + AT_KBYTES + (vrow + 32) * AT_VSTR + vch * 16) = sv1; } while (0)
        AT_LOAD(0); AT_WRITE(lds);
        __syncthreads();
        for (int kt = 0; kt < ntile; ++kt) {
            const bool more = kt + 1 < ntile;
            if (more) AT_LOAD(kt + 1);
            const LAS unsigned char* kb = lds + (kt & 1) * AT_BUF; const LAS unsigned char* vb = kb + AT_KBYTES;
            f32x4 st[8][2];
#pragma unroll
            for (int k4 = 0; k4 < 8; ++k4) {
                bf16x8 kf[3];
#pragma unroll
                for (int ks = 0; ks < 3; ++ks) kf[ks] = *(const LAS bf16x8*)(kb + (k4 * 16 + fr) * AT_KSTR + ks * 64 + fq * 16);
#pragma unroll
                for (int qb = 0; qb < 2; ++qb) { const float nm = -mrow[qb]; f32x4 acc = (f32x4){nm, nm, nm, nm};
#pragma unroll
                    for (int ks = 0; ks < 3; ++ks) acc = __builtin_amdgcn_mfma_f32_16x16x32_bf16(kf[ks], qf[qb][ks], acc, 0, 0, 0);
                    st[k4][qb] = acc; }
            }
            bf16x8 pb[2][4];
            float mxr[2];
#pragma unroll
            for (int qb = 0; qb < 2; ++qb) {
                float mx = fmaxf(fmaxf(st[0][qb][0], st[0][qb][1]), fmaxf(st[0][qb][2], st[0][qb][3]));
#pragma unroll
                for (int k4 = 1; k4 < 8; ++k4) mx = fmaxf(mx, fmaxf(fmaxf(st[k4][qb][0], st[k4][qb][1]), fmaxf(st[k4][qb][2], st[k4][qb][3])));
                mx = fmaxf(mx, __shfl_xor(mx, 16)); mxr[qb] = fmaxf(mx, __shfl_xor(mx, 32));
            }
            if (__any((kt == 0) || (fmaxf(mxr[0], mxr[1]) > 8.f))) {
#pragma unroll
                for (int qb = 0; qb < 2; ++qb) { const float delta = (kt == 0) ? mxr[qb] : fmaxf(mxr[qb], 0.f), alpha = __builtin_amdgcn_exp2f(-delta);
                    mrow[qb] += delta; lrow[qb] *= alpha;
#pragma unroll
                    for (int d = 0; d < 4; ++d) ot[d][qb] = ot[d][qb] * alpha;
#pragma unroll
                    for (int k4 = 0; k4 < 8; ++k4) st[k4][qb] = st[k4][qb] - delta; }
            }
#pragma unroll
            for (int hf = 0; hf < 2; ++hf) {
#pragma unroll
                for (int qb = 0; qb < 2; ++qb) {
                    float rs = 0.f;
#pragma unroll
                    for (int k4 = 4 * hf; k4 < 4 * hf + 4; ++k4)
#pragma unroll
                        for (int j = 0; j < 4; ++j) { const float p = __builtin_amdgcn_exp2f(st[k4][qb][j]); st[k4][qb][j] = p; rs += p; }
                    lrow[qb] += rs;
#pragma unroll
                    for (int ks = 2 * hf; ks < 2 * hf + 2; ++ks) pb[qb][ks] = pack_frag(st[2 * ks][qb], st[2 * ks + 1][qb]);
                }
#pragma unroll
                for (int d = 0; d < 4; ++d)
#pragma unroll
                    for (int ks = 2 * hf; ks < 2 * hf + 2; ++ks) {
                        const u32x2 lo = *(const LAS u32x2*)(vb + (d * 16 + fr) * AT_VSTR + (ks * 32 + fq * 4) * 2), hi = *(const LAS u32x2*)(vb + (d * 16 + fr) * AT_VSTR + (ks * 32 + 16 + fq * 4) * 2);
                        const u32x4 vv = (u32x4){lo.x, lo.y, hi.x, hi.y}; const bf16x8 vf = __builtin_bit_cast(bf16x8, vv);
#pragma unroll
                        for (int qb = 0; qb < 2; ++qb) ot[d][qb] = __builtin_amdgcn_mfma_f32_16x16x32_bf16(vf, pb[qb][ks], ot[d][qb], 0, 0, 0);
                    }
            }
            if (more) AT_WRITE(lds + ((kt + 1) & 1) * AT_BUF);
            __syncthreads();
        }
#undef AT_LOAD
#undef AT_WRITE
#pragma unroll
        for (int qb = 0; qb < 2; ++qb) {
            float l = lrow[qb]; l += __shfl_xor(l, 16); l += __shfl_xor(l, 32); const float inv = 1.f / l;
            bf16* op = MIX + (tb + q0 + wave * 32 + qb * 16 + fr) * D + 512 + h * 64 + fq * 4;
#pragma unroll
            for (int d = 0; d < 4; ++d) { u32x2 o; o.x = cvt_pk_bf16(ot[d][qb][0] * inv, ot[d][qb][1] * inv); o.y = cvt_pk_bf16(ot[d][qb][2] * inv, ot[d][qb][3] * inv); *(u32x2*)(op + d * 16) = o; }
        }
    }
}

constexpr int CLQ = 0, CLK = 17408, CLV = 34816, CLKK = 52224, CLQK = 68864, CLLN = 85504  , CLLD = 102912  ,
              CLDI = 111104  , CLG = 116224;
DI int kperm(int ks, int fq, int j) { return 32 * ks + 16 * (j >> 2) + 4 * fq + (j & 3); }
DI bf16x8 frag_lo(const u32x2 v) { const u32x4 w = (u32x4){v.x, v.y, 0u, 0u}; return __builtin_bit_cast(bf16x8, w); }
DI bf16x8 frag_lh(const u32x2 a, const u32x2 b) { const u32x4 w = (u32x4){a.x, a.y, b.x, b.y}; return __builtin_bit_cast(bf16x8, w); }
DI void gdn_chunk_phase(unsigned char* ws, LAS unsigned char* lds, int G, int bx) {
    const bf16* QN = (const bf16*)(ws + WS_R1); const float* GB = (const float*)(ws + WS_GB); unsigned char* CL = ws + WS_R0; float* GEND = (float*)(ws + WS_GEND);
    LAS float* KKs = (LAS float*)(lds + CLKK); LAS float* QKs = (LAS float*)(lds + CLQK); LAS float* gcs = (LAS float*)(lds + CLG);
    u32x4 pre[3][2]; float pg[4] = {0.f, 0.f, 0.f, 0.f};
    { int tid0 = threadIdx.x; asm volatile("" : "+v"(tid0));
      if (bx < NB * 8 * 36) { const int u = bx, b = u / 288, h = (u / 36) & 7, blk = u % 36; const size_t t0 = (size_t)b * LT + blk * 64;
#pragma unroll
        for (int mtx = 0; mtx < 3; ++mtx)
#pragma unroll
            for (int i = 0; i < 2; ++i) { const int id = tid0 + 512 * i, row = id >> 4, ch = id & 15; pre[mtx][i] = *(const u32x4*)(QN + (t0 + row) * 3072 + mtx * 1024 + h * 128 + ch * 8); }
        if (tid0 < 64) { const float* gp = GB + (t0 + tid0) * 32; pg[0] = gp[h]; pg[1] = gp[8 + h]; pg[2] = gp[16 + h]; pg[3] = gp[24 + h]; } } }
    for (int u = bx; u < NB * 8 * 36; u += G) {
        int tid = threadIdx.x; asm volatile("" : "+v"(tid));
        const int lane = tid & 63, wave = __builtin_amdgcn_readfirstlane(tid >> 6), fr = lane & 15, fq = lane >> 4;
        const int b = u / 288, h = (u / 36) & 7, blk = u % 36;
#pragma unroll
        for (int mtx = 0; mtx < 3; ++mtx)
#pragma unroll
            for (int i = 0; i < 2; ++i) { const int id = tid + 512 * i, row = id >> 4, ch = id & 15; *(LAS u32x4*)(lds + mtx * 17408 + row * 272 + ch * 16) = pre[mtx][i]; }
        if (wave == 0) { float gf = pg[0], gb = pg[1]; const float bf_ = pg[2], bb_ = pg[3];
#pragma unroll
            for (int o = 1; o < 64; o <<= 1) { const float x = __shfl_up(gf, o); if (lane >= o) gf += x; const float y = __shfl_down(gb, o); if (lane + o < 64) gb += y; }
            const float ef = __expf(gf), eb = __expf(gb); gcs[lane] = gf; gcs[64 + lane] = gb; gcs[128 + lane] = bf_; gcs[192 + lane] = bb_; gcs[256 + lane] = bf_ * ef; gcs[320 + lane] = bb_ * eb; gcs[384 + lane] = ef; gcs[448 + lane] = eb;
            const float glf = __shfl(gf, 63), glb = __shfl(gb, 0); gcs[512 + lane] = __expf(glf - gf); gcs[576 + lane] = __expf(glb - gb); }
        if (u + G < NB * 8 * 36) { const int un = u + G, bn = un / 288, hn = (un / 36) & 7, blkn = un % 36; const size_t t0n = (size_t)bn * LT + blkn * 64;
#pragma unroll
            for (int mtx = 0; mtx < 3; ++mtx)
#pragma unroll
                for (int i = 0; i < 2; ++i) { const int id = tid + 512 * i, row = id >> 4, ch = id & 15; pre[mtx][i] = *(const u32x4*)(QN + (t0n + row) * 3072 + mtx * 1024 + hn * 128 + ch * 8); }
            if (wave == 0) { const float* gp = GB + (t0n + lane) * 32; pg[0] = gp[hn]; pg[1] = gp[8 + hn]; pg[2] = gp[16 + hn]; pg[3] = gp[24 + hn]; } }
        __syncthreads();
        { const int rb = wave & 3; const bool iskk = wave < 4; const LAS unsigned char* Am = lds + (iskk ? CLK : CLQ);
          bf16x8 af[4];
#pragma unroll
          for (int ks = 0; ks < 4; ++ks) af[ks] = *(const LAS bf16x8*)(Am + (rb * 16 + fr) * 272 + ks * 64 + fq * 16);
#pragma unroll
          for (int cb = 0; cb < 4; ++cb) { f32x4 acc = (f32x4){0.f, 0.f, 0.f, 0.f};
#pragma unroll
              for (int ks = 0; ks < 4; ++ks) { const bf16x8 bfr = *(const LAS bf16x8*)(lds + CLK + (cb * 16 + fr) * 272 + ks * 64 + fq * 16); acc = __builtin_amdgcn_mfma_f32_16x16x32_bf16(af[ks], bfr, acc, 0, 0, 0); }
              if (!iskk) {
#pragma unroll
                  for (int j = 0; j < 4; ++j) QKs[(rb * 16 + fq * 4 + j) * 65 + cb * 16 + fr] = acc[j];
              } else { const int sj = cb * 16 + fr; const float gfj = gcs[sj], gbj = gcs[64 + sj];
#pragma unroll
                  for (int j = 0; j < 4; ++j) { const int si = rb * 16 + fq * 4 + j; const float kk = acc[j];
                      const float vf = (sj < si) ? gcs[128 + si] * kk * __expf(fminf(gcs[si] - gfj, 0.f)) : 0.f;
                      const float vb = (sj > si) ? gcs[192 + si] * kk * __expf(fminf(gcs[64 + si] - gbj, 0.f)) : 0.f;
                      *(LAS unsigned short*)(lds + CLLN + si * 136 + sj * 2) = (unsigned short)f2bf(-vf);
                      *(LAS unsigned short*)(lds + CLLN + 8704 + (63 - si) * 136 + (63 - sj) * 2) = (unsigned short)f2bf(-vb);
                      if (cb == rb) { ((LAS float*)(lds + CLLD))[((0 * 4 + rb) * 16 + (si & 15)) * 16 + (sj & 15)] = vf;
                                      ((LAS float*)(lds + CLLD))[((1 * 4 + (3 - rb)) * 16 + ((63 - si) & 15)) * 16 + ((63 - sj) & 15)] = vb; } } } } }
        __syncthreads();
        if (wave < 2) {
            const int r = lane >> 4, c = lane & 15; const LAS float* Lb = (const LAS float*)(lds + CLLD) + (wave * 4 + r) * 256;
            float y[16];
#pragma unroll
            for (int i = 0; i < 16; ++i) { float acc = (i == c) ? 1.f : 0.f;
#pragma unroll
                for (int c4 = 0; c4 < (i + 3) / 4; ++c4) { const f32x4 lv = *(const LAS f32x4*)(Lb + i * 16 + c4 * 4);
#pragma unroll
                    for (int jj = 0; jj < 4; ++jj) if (c4 * 4 + jj < i) acc -= lv[jj] * y[c4 * 4 + jj]; }
                y[i] = acc;
                *(LAS unsigned short*)(lds + CLDI + ((wave * 4 + r) * 16 + i) * 40 + c * 2) = (unsigned short)f2bf(acc); }
        } else {
            const int lfr = lane & 15, lfq = lane >> 4;
            for (int f2 = wave - 2; f2 < 80; f2 += 6) { const int dir = f2 >= 40 ? 1 : 0, f = f2 - 40 * dir, dmk = dir ? 63 : 0;
                unsigned char* dst = CL + (size_t)(((b * 8 + h) * 2 + dir) * 36 + blk) * CL_BYTES; const LAS float* gc = gcs + dir * 64;
                float v[8];
                if (f < 16) { const int rb = f >> 2, ks = f & 3, i = rb * 16 + lfr, s = i ^ dmk; const float e = gcs[384 + dir * 64 + s];
                    const u32x2 lo = *(const LAS u32x2*)(lds + CLQ + s * 272 + (ks * 32 + lfq * 4) * 2), hi = *(const LAS u32x2*)(lds + CLQ + s * 272 + (ks * 32 + 16 + lfq * 4) * 2);
                    v[0] = bf2f(lo.x & 0xffffu) * e; v[1] = bf2f(lo.x >> 16) * e; v[2] = bf2f(lo.y & 0xffffu) * e; v[3] = bf2f(lo.y >> 16) * e; v[4] = bf2f(hi.x & 0xffffu) * e; v[5] = bf2f(hi.x >> 16) * e; v[6] = bf2f(hi.y & 0xffffu) * e; v[7] = bf2f(hi.y >> 16) * e;
                    u32x4 o; o.x = cvt_pk_bf16(v[0], v[1]); o.y = cvt_pk_bf16(v[2], v[3]); o.z = cvt_pk_bf16(v[4], v[5]); o.w = cvt_pk_bf16(v[6], v[7]);
                    *(u32x4*)(dst + CL_QG + (size_t)(f * 64 + lane) * 16) = o;
                } else if (f < 32) { const int g = f - 16, rb = g >> 1, ks = g & 1, dk = rb * 16 + lfr; const LAS float* ekd = gcs + 512 + dir * 64;
#pragma unroll
                    for (int j = 0; j < 8; ++j) { const int s = kperm(ks, lfq, j) ^ dmk; v[j] = bf2f(*(const LAS unsigned short*)(lds + CLK + s * 272 + dk * 2)) * ekd[s]; }
                    u32x4 o; o.x = cvt_pk_bf16(v[0], v[1]); o.y = cvt_pk_bf16(v[2], v[3]); o.z = cvt_pk_bf16(v[4], v[5]); o.w = cvt_pk_bf16(v[6], v[7]);
                    *(u32x4*)(dst + CL_KDT + (size_t)(g * 64 + lane) * 16) = o;
                } else { const int g = f - 32, rb = g >> 1, ks = g & 1, i = rb * 16 + lfr, si = i ^ dmk; const float gi = gc[si];
#pragma unroll
                    for (int j = 0; j < 8; ++j) { const int jj = kperm(ks, lfq, j), sj = jj ^ dmk; v[j] = (jj <= i) ? QKs[si * 65 + sj] * __expf(fminf(gi - gc[sj], 0.f)) : 0.f; }
                    u32x4 o; o.x = cvt_pk_bf16(v[0], v[1]); o.y = cvt_pk_bf16(v[2], v[3]); o.z = cvt_pk_bf16(v[4], v[5]); o.w = cvt_pk_bf16(v[6], v[7]);
                    *(u32x4*)(dst + CL_ATT + (size_t)(g * 64 + lane) * 16) = o; }
            }
            if (tid >= 128 && tid < 130) { const int t2 = tid - 128; GEND[((b * 8 + h) * 2 + t2) * 36 + blk] = t2 ? gcs[448] : gcs[384 + 63]; }
        }
        __syncthreads();
        {
            const f32x4 z4 = (f32x4){0.f, 0.f, 0.f, 0.f};
            f32x4 R[4][4];
#pragma unroll
            for (int q = 0; q < 4; ++q) { const int dir = q >> 1, isw = q & 1, dm = dir ? 63 : 0;
                const LAS unsigned char* Sm = lds + (isw ? CLK : CLV) + (16 * wave + fr) * 2; const LAS float* scp = gcs + 128 + isw * 128 + dir * 64;
#pragma unroll
                for (int r = 0; r < 4; ++r)
#pragma unroll
                    for (int j = 0; j < 4; ++j) { const int s = (16 * r + 4 * fq + j) ^ dm; R[q][r][j] = bf2f(*(const LAS unsigned short*)(Sm + s * 272)) * scp[s]; } }
#define LNP(dir) (lds + CLLN + (dir) * 8704 + fr * 136 + fq * 8)
#define DIP(dir) (lds + CLDI + ((dir) * 4 * 16 + fr) * 40 + fq * 8)
#define DI_FRAG(dir, r) frag_lo(*(const LAS u32x2*)(DIP(dir) + (r) * 640))
#define LN_FRAG2(dir, r, c0, c1) frag_lh(*(const LAS u32x2*)(LNP(dir) + (r) * 2176 + (c0) * 32), *(const LAS u32x2*)(LNP(dir) + (r) * 2176 + (c1) * 32))
#define LN_FRAG1(dir, r, c0) frag_lo(*(const LAS u32x2*)(LNP(dir) + (r) * 2176 + (c0) * 32))
            f32x4 X[4][4]; bf16x8 b01[4];
            { const bf16x8 d0[2] = {DI_FRAG(0, 0), DI_FRAG(1, 0)};
#pragma unroll
              for (int q = 0; q < 4; ++q) X[q][0] = __builtin_amdgcn_mfma_f32_16x16x32_bf16(d0[q >> 1], pack_frag(R[q][0], z4), z4, 0, 0, 0); }
            { const bf16x8 l10[2] = {LN_FRAG1(0, 1, 0), LN_FRAG1(1, 1, 0)}, d1[2] = {DI_FRAG(0, 1), DI_FRAG(1, 1)};
#pragma unroll
              for (int q = 0; q < 4; ++q) R[q][1] = __builtin_amdgcn_mfma_f32_16x16x32_bf16(l10[q >> 1], pack_frag(X[q][0], z4), R[q][1], 0, 0, 0);
#pragma unroll
              for (int q = 0; q < 4; ++q) X[q][1] = __builtin_amdgcn_mfma_f32_16x16x32_bf16(d1[q >> 1], pack_frag(R[q][1], z4), z4, 0, 0, 0); }
#pragma unroll
            for (int q = 0; q < 4; ++q) b01[q] = pack_frag(X[q][0], X[q][1]);
            { const bf16x8 l2[2] = {LN_FRAG2(0, 2, 0, 1), LN_FRAG2(1, 2, 0, 1)}, d2[2] = {DI_FRAG(0, 2), DI_FRAG(1, 2)}, l3[2] = {LN_FRAG2(0, 3, 0, 1), LN_FRAG2(1, 3, 0, 1)};
#pragma unroll
              for (int q = 0; q < 4; ++q) { R[q][2] = __builtin_amdgcn_mfma_f32_16x16x32_bf16(l2[q >> 1], b01[q], R[q][2], 0, 0, 0); R[q][3] = __builtin_amdgcn_mfma_f32_16x16x32_bf16(l3[q >> 1], b01[q], R[q][3], 0, 0, 0); }
#pragma unroll
              for (int q = 0; q < 4; ++q) X[q][2] = __builtin_amdgcn_mfma_f32_16x16x32_bf16(d2[q >> 1], pack_frag(R[q][2], z4), z4, 0, 0, 0); }
            { const bf16x8 l32[2] = {LN_FRAG1(0, 3, 2), LN_FRAG1(1, 3, 2)}, d3[2] = {DI_FRAG(0, 3), DI_FRAG(1, 3)};
#pragma unroll
              for (int q = 0; q < 4; ++q) R[q][3] = __builtin_amdgcn_mfma_f32_16x16x32_bf16(l32[q >> 1], pack_frag(X[q][2], z4), R[q][3], 0, 0, 0);
#pragma unroll
              for (int q = 0; q < 4; ++q) X[q][3] = __builtin_amdgcn_mfma_f32_16x16x32_bf16(d3[q >> 1], pack_frag(R[q][3], z4), z4, 0, 0, 0); }
#undef LNP
#undef DIP
#undef DI_FRAG
#undef LN_FRAG2
#undef LN_FRAG1
#pragma unroll
            for (int q = 0; q < 4; ++q) { const int dir = q >> 1, isw = q & 1;
                unsigned char* dst = CL + (size_t)(((b * 8 + h) * 2 + dir) * 36 + blk) * CL_BYTES;
                if (!isw) {
#pragma unroll
                    for (int r = 0; r < 4; ++r) { u32x2 o; o.x = cvt_pk_bf16(X[q][r][0], X[q][r][1]); o.y = cvt_pk_bf16(X[q][r][2], X[q][r][3]); *(u32x2*)(dst + CL_UT + (size_t)((wave * 4 + r) * 64 + lane) * 8) = o; }
                } else {
                    LAS unsigned char* tp = lds + CLQ + wave * 2048 + (q >> 1) * 1024;
#pragma unroll
                    for (int r = 0; r < 4; ++r) {
#pragma unroll
                        for (int j = 0; j < 4; ++j) *(LAS unsigned short*)(tp + ((r & 1) * 512) + ((4 * fq + j) * 16 + fr) * 2) = (unsigned short)f2bf(X[q][r][j]);
                        LDS_WAIT();
                        const LAS unsigned* rp_ = (const LAS unsigned*)(tp + ((r & 1) * 512) + (fr * 16 + 4 * fq) * 2); u32x2 t8; t8.x = rp_[0]; t8.y = rp_[1];
                        *(u32x2*)(dst + CL_W + (size_t)((r * 4 + (wave >> 1)) * 64 + lane) * 16 + (wave & 1) * 8) = t8;
                    }
                    LDS_WAIT();
                }
            }
        }
        __syncthreads();
    }
}

DI void gdn_scan_phase(unsigned char* ws, LAS unsigned char* lds, int G, int bx) {
    int tid = threadIdx.x; asm volatile("" : "+v"(tid));
    const int lane = tid & 63, wave = __builtin_amdgcn_readfirstlane(tid >> 6), gw = bx * NWAVES + wave, NGW = G * NWAVES, gtid = bx * NTHR + tid, NGT = G * NTHR;
    (void)lane; (void)wave; (void)gw; (void)NGW; (void)gtid; (void)NGT;
    const unsigned char* CL = ws + WS_R0; const float* GEND = (const float*)(ws + WS_GEND);
    const int fr = lane & 15, fq = lane >> 4, th = wave >> 2, n = wave & 3;
    for (int u0 = bx; u0 < 256; u0 += G) {
        const int u = (G % 16 == 0) ? ((u0 & ~15) | ((u0 & 7) << 1) | ((u0 >> 3) & 1)) : u0;
        const int b = u >> 5, h = (u >> 2) & 7, dir = (u >> 1) & 1, hv = u & 1; const int cbase = ((b * 8 + h) * 2 + dir) * 36;
        bf16* OX = (bf16*)(ws + WS_R1) + (size_t)dir * T * D;
        f32x4 S[8];
#pragma unroll
        for (int r = 0; r < 8; ++r) S[r] = (f32x4){0.f, 0.f, 0.f, 0.f};
#define GS_LOAD(step, bufi) do { const int blk_ = dir ? ((step) < 4 ? 3 - (step) : 39 - (step)) : (step); const unsigned char* src_ = CL + (size_t)(cbase + blk_) * CL_BYTES; \
        _Pragma("unroll") for (int i_ = 0; i_ < 8; ++i_) { const unsigned char* g_ = (i_ < 7) ? src_ + (size_t)(tid + 512 * i_) * 16 : src_ + CL_UT + (size_t)hv * 8192 + (size_t)tid * 16; \
            __builtin_amdgcn_global_load_lds((const unsigned*)g_, (LAS unsigned*)(lds + (bufi) * 65536 + (wave * 64 + 512 * i_) * 16), 16, 0, 0); } } while (0)
        GS_LOAD(0, 0);
        LAS float* gtab = (LAS float*)(lds + 131072 + 512);
        if (tid < 36) { const int blk_ = dir ? (tid < 4 ? 3 - tid : 39 - tid) : tid; gtab[tid] = GEND[cbase + blk_]; }
        VM_WAIT(); __syncthreads();
        for (int step = 0; step < 36; ++step) {
            const int blk = dir ? (step < 4 ? 3 - step : 39 - step) : step;
            if (step + 1 < 36) GS_LOAD(step + 1, (step + 1) & 1);
            const LAS unsigned char* bb = lds + (step & 1) * 65536;
            const float gend = gtab[step];
            if (wave < 4) {
            bf16x8 sb[4];
#pragma unroll
            for (int ks = 0; ks < 4; ++ks) sb[ks] = pack_frag(S[2 * ks], S[2 * ks + 1]);
            f32x4 vn[4];
#pragma unroll
            for (int tb = 0; tb < 4; ++tb) { f32x4 acc = (f32x4){0.f, 0.f, 0.f, 0.f};
#pragma unroll
                for (int ks = 0; ks < 4; ++ks) acc = __builtin_amdgcn_mfma_f32_16x16x32_bf16(*(const LAS bf16x8*)(bb + CL_W + ((tb * 4 + ks) * 64 + lane) * 16), sb[ks], acc, 0, 0, 0);
                const u32x2 up = *(const LAS u32x2*)(bb + 57344 + ((n * 4 + tb) * 64 + lane) * 8);
                vn[tb][0] = bf2f(up.x & 0xffffu) - acc[0]; vn[tb][1] = bf2f(up.x >> 16) - acc[1]; vn[tb][2] = bf2f(up.y & 0xffffu) - acc[2]; vn[tb][3] = bf2f(up.y >> 16) - acc[3]; }
            bf16x8 vb[2];
            vb[0] = pack_frag(vn[0], vn[1]); vb[1] = pack_frag(vn[2], vn[3]);
#pragma unroll
            for (int tq = 0; tq < 4; ++tq) { const int tb = tq; f32x4 acc = (f32x4){0.f, 0.f, 0.f, 0.f};
#pragma unroll
                for (int ks = 0; ks < 4; ++ks) acc = __builtin_amdgcn_mfma_f32_16x16x32_bf16(*(const LAS bf16x8*)(bb + CL_QG + ((tb * 4 + ks) * 64 + lane) * 16), sb[ks], acc, 0, 0, 0);
#pragma unroll
                for (int ks = 0; ks < 2; ++ks) acc = __builtin_amdgcn_mfma_f32_16x16x32_bf16(*(const LAS bf16x8*)(bb + CL_ATT + ((tb * 2 + ks) * 64 + lane) * 16), vb[ks], acc, 0, 0, 0);
#pragma unroll
                for (int j = 0; j < 4; ++j) { const int i = tb * 16 + fq * 4 + j, s = blk * 64 + (dir ? 63 - i : i);
                    OX[((size_t)b * LT + s) * D + h * 128 + (hv * 4 + n) * 16 + fr] = (bf16)f2bf(acc[j]); } }
#pragma unroll
            for (int rb = 0; rb < 8; ++rb) { f32x4 acc = S[rb] * gend;
#pragma unroll
                for (int ks = 0; ks < 2; ++ks) acc = __builtin_amdgcn_mfma_f32_16x16x32_bf16(*(const LAS bf16x8*)(bb + CL_KDT + ((rb * 2 + ks) * 64 + lane) * 16), vb[ks], acc, 0, 0, 0);
                S[rb] = acc; }
            }
            VM_WAIT(); __syncthreads();
        }
#undef GS_LOAD
    }
}

constexpr int NPH = 45, LDS_BYTES = 147456, MISC_OFF = 131072;
#ifndef PHSEL
#define PHSEL 0xffffffffu
#endif
#define PHON(b) ((PHSEL >> (b)) & 1u)
#ifndef DUPSEL
#define DUPSEL 0u
#endif
#ifndef DUPN
#define DUPN 2
#endif
#define NREP(b) (((DUPSEL >> (b)) & 1u) ? DUPN : 1)
#define IN(k) (lo <= (k) && (k) < hi)
#define SEAM(k) do { if (IN(k) && IN((k) + 1)) xcd_barrier(bar); } while (0)
template <int lp>
DI void layer_pair(const Args& args, unsigned char* ws, LAS unsigned char* lds, const int G, const int bx, const XcdBarrier& bar, const int lo, const int hi) {
    bf16* const H = (bf16*)(ws + WS_H); bf16* const XS = (bf16*)(ws + WS_XS); const float* const MOD = (const float*)(ws + WS_MOD);
    unsigned char* const wb = ws + WS_W; unsigned char* const wo = ws + WS_WO; unsigned char* const r0 = ws + WS_R0; unsigned char* const r1 = ws + WS_R1;
    const int tid = threadIdx.x;

        const int pb = 2 + 21 * lp, le = 2 * lp, lodd = 2 * lp + 1;
        if (PHON(1) && IN(pb + 0)) { for (int rep_ = 0; rep_ < NREP(15); ++rep_) convert_layer(args, ws, le, lds, G, bx); norm_phase(args, ws, le, 0, G, bx); }
        SEAM(pb + 0);
        if (PHON(2) && IN(pb + 1)) { for (int rep_ = 0; rep_ < NREP(2); ++rep_) { pg8::DenseOrder S; S.init(H, D, (const bf16*)(wb + WE_IN), D, T, EVEN_INP, G, bx); EpiStoreBf16 E{(bf16*)(r0 + RE_P), EVEN_INP};
            pg8::gemm_phase<EpiStoreBf16, pg8::DenseOrder, D, D, D>(lds, S, E);  } }
        SEAM(pb + 1);
        if (PHON(3) && IN(pb + 2)) { for (int rep_ = 0; rep_ < NREP(3); ++rep_) { even_mid_phase(args, ws, le, G, bx);  } }
        SEAM(pb + 2);
        if (PHON(11) && IN(pb + 3)) { for (int rep_ = 0; rep_ < NREP(11); ++rep_) { pg8::DenseOrder S; S.init((const bf16*)(r0 + RE_A2), UP_K, (const bf16*)(wb + WE_UP), UP_K, T, UP_N, G, bx);
            EpiUp E{(bf16*)(r0 + RE_Q), (bf16*)(r0 + RE_KN), (bf16*)(r0 + RE_VT), (const float*)(ws + WS_ROPE), (const float*)(ws + WS_ROPE) + 2048 * 16};
            pg8::gemm_phase<EpiUp, pg8::DenseOrder, UP_K, UP_K, UP_K>(lds, S, E);  } }
        SEAM(pb + 3);
        if (PHON(4) && IN(pb + 4)) { for (int rep_ = 0; rep_ < NREP(4); ++rep_) { attn_phase(ws, lds, G, bx);  } }
        SEAM(pb + 4);
        if (PHON(12) && IN(pb + 5)) { pg8::DenseOrder S; S.init((const bf16*)(r0 + RE_MIX), D, (const bf16*)(wb + WE_OUT), D, T, D, G, bx); EpiResid E{XS, MOD + (size_t)le * 9 * 6144 + 2 * 1024};
            pg8::gemm_phase<EpiResid, pg8::DenseOrder, D, D, D>(lds, S, E);
            if (bx >= 32) convert_moe(args, ws, lodd, lds, (bx - 32) * NWAVES + __builtin_amdgcn_readfirstlane(tid >> 6), (G - 32) * NWAVES, 0, MOE_Q1); }
        SEAM(pb + 5);
        if (PHON(1) && IN(pb + 6)) { for (int rep_ = 0; rep_ < NREP(16); ++rep_) norm_phase(args, ws, le, 1, G, bx); }
        SEAM(pb + 6);
        if (PHON(13) && IN(pb + 7)) { for (int rep_ = 0; rep_ < NREP(13); ++rep_) { pg8::DenseOrder S; S.init(H, D, (const bf16*)(wb + WE_W1), D, T, 2 * FFN_F, G, bx); EpiSwiglu E{(bf16*)(r0 + RE_ACT), FFN_F};
            pg8::gemm_phase<EpiSwiglu, pg8::DenseOrder, D, D, D>(lds, S, E);  } }
        SEAM(pb + 7);
        if (PHON(12) && IN(pb + 8)) { pg8::DenseOrder S; S.init((const bf16*)(r0 + RE_ACT), FFN_F, (const bf16*)(wb + WE_W2), FFN_F, T, D, G, bx); EpiResid E{XS, MOD + (size_t)le * 9 * 6144 + 5 * 1024};
            pg8::gemm_phase<EpiResid, pg8::DenseOrder, FFN_F, FFN_F, FFN_F>(lds, S, E);
            if (bx >= 32) convert_moe(args, ws, lodd, lds, (bx - 32) * NWAVES + __builtin_amdgcn_readfirstlane(tid >> 6), (G - 32) * NWAVES, MOE_Q1, MOE_Q2); }
        SEAM(pb + 8);
        if (PHON(1) && IN(pb + 9)) { for (int rep_ = 0; rep_ < NREP(15); ++rep_) { convert_layer(args, ws, lodd, lds, G, bx); convert_moe(args, ws, lodd, lds, bx * NWAVES + __builtin_amdgcn_readfirstlane(tid >> 6), G * NWAVES, MOE_Q2, MOE_ITEMS); } norm_phase(args, ws, lodd, 0, G, bx); }
        SEAM(pb + 9);
        if (PHON(14) && IN(pb + 10)) { for (int rep_ = 0; rep_ < NREP(14); ++rep_) { pg8::DenseOrder S; S.init(H, D, (const bf16*)(wo + WO_IN), D, T, ODD_INP, G, bx); EpiOddIn E{(bf16*)r0, (bf16*)(ws + WS_R2), (float*)(ws + WS_AB)};
            pg8::gemm_phase<EpiOddIn, pg8::DenseOrder, D, D, D>(lds, S, E);  } }
        SEAM(pb + 10);
        if (PHON(5) && IN(pb + 11)) { for (int rep_ = 0; rep_ < NREP(5); ++rep_) { odd_mid_phase(args, ws, lodd, lds, G, bx);  } }
        SEAM(pb + 11);
        if (PHON(6) && IN(pb + 12)) { for (int rep_ = 0; rep_ < NREP(6); ++rep_) { gdn_chunk_phase(ws, lds, G, bx);  } }
        SEAM(pb + 12);
        if (PHON(7) && IN(pb + 13)) { for (int rep_ = 0; rep_ < NREP(7); ++rep_) { gdn_scan_phase(ws, lds, G, bx);  } }
        SEAM(pb + 13);
        if (PHON(8) && IN(pb + 14)) { for (int rep_ = 0; rep_ < NREP(8); ++rep_) { odd_post_phase(args, ws, lodd, G, bx);  } }
        SEAM(pb + 14);
        if (PHON(12) && IN(pb + 15)) { pg8::DenseOrder S; S.init((const bf16*)r1 + (size_t)2 * T * D, D, (const bf16*)(wo + WO_OUT), D, T, D, G, bx, lodd == 3); EpiResid E{XS, MOD + (size_t)lodd * 9 * 6144 + 2 * 1024};
            pg8::gemm_phase<EpiResid, pg8::DenseOrder, D, D, D>(lds, S, E); }
        SEAM(pb + 15);
        if (PHON(1) && IN(pb + 16)) { norm_phase(args, ws, lodd, 1, G, bx); }
        SEAM(pb + 16);
        if (PHON(1) && IN(pb + 17)) { route_assign_phase(ws, lodd, G, bx); }
        SEAM(pb + 17);
        if (IN(pb + 18) || IN(pb + 19) || IN(pb + 20)) { LAS int* tab = (LAS int*)(lds + MISC_OFF + 64);
            if (tid < NEXP) tab[tid] = (int)__hip_atomic_load((unsigned*)(ws + WS_CTL) + CW_CNT + (lp * 8 + tid) * 64, __ATOMIC_RELAXED, __HIP_MEMORY_SCOPE_AGENT);
            __syncthreads(); }
        if (PHON(9) && IN(pb + 18)) { for (int rep_ = 0; rep_ < NREP(9); ++rep_) { MoeOrder<true> S{H, (const bf16*)(wo + WO_W1), D, D, (size_t)2 * MOE_F * D, (const int*)(ws + WS_LIST), (const LAS int*)(lds + MISC_OFF + 64), 28, G, (G % 8 == 0) ? (bx & 7) * (G >> 3) + (bx >> 3) : bx, 0x7fffffff}; EpiSwiglu E{(bf16*)r0, MOE_F};
            pg8::gemm_phase<EpiSwiglu, MoeOrder<true>, D, D, D>(lds, S, E);  } }
        SEAM(pb + 18);
        int moeU = 0;
        if (IN(pb + 19) || IN(pb + 20)) { const LAS int* tabp = (const LAS int*)(lds + MISC_OFF + 64);
#pragma unroll
            for (int e = 0; e < NEXP; ++e) moeU += ((tabp[e] + 255) >> 8) * 4; }
        const int moeFull = (moeU / G) * G, moeR = moeU - moeFull, moeS = (moeR == 0) ? 1 : (4 * moeR <= G ? 4 : (2 * moeR <= G ? 2 : 1));
        bf16* const PB = (bf16*)(ws + WS_END);
        if (PHON(10) && IN(pb + 19)) { for (int rep_ = 0; rep_ < NREP(10); ++rep_) {
            MoeOrder<false> S{(const bf16*)r0, (const bf16*)(wo + WO_W2), MOE_F, MOE_F, (size_t)D * MOE_F, (const int*)(ws + WS_LIST), (const LAS int*)(lds + MISC_OFF + 64), 4, G, (G % 8 == 0) ? (bx & 7) * (G >> 3) + (bx >> 3) : bx, moeS > 1 ? moeFull : moeU};
            { EpiMoeDown E{(bf16*)r1, (const float*)(ws + WS_GW)}; pg8::gemm_phase<EpiMoeDown, MoeOrder<false>, MOE_F, MOE_F, MOE_F>(lds, S, E); }
            if (moeS == 2) { MoeTailOrder TS{S, moeFull, moeR, 2, MOE_F / 2}; EpiMoeDownPart E{PB, (const float*)(ws + WS_GW)}; pg8::gemm_phase<EpiMoeDownPart, MoeTailOrder, MOE_F / 2, MOE_F, MOE_F>(lds, TS, E); }
            else if (moeS == 4) { MoeTailOrder TS{S, moeFull, moeR, 4, MOE_F / 4}; EpiMoeDownPart E{PB, (const float*)(ws + WS_GW)}; pg8::gemm_phase<EpiMoeDownPart, MoeTailOrder, MOE_F / 4, MOE_F, MOE_F>(lds, TS, E); }
        } }
        SEAM(pb + 19);
        if (DBG_CHECK && PHON(10) && IN(pb + 20) && moeS > 1) {
            MoeOrder<false> S{(const bf16*)r0, (const bf16*)(wo + WO_W2), MOE_F, MOE_F, (size_t)D * MOE_F, (const int*)(ws + WS_LIST), (const LAS int*)(lds + MISC_OFF + 64), 4, G, bx, moeU};
            int tz = threadIdx.x; asm volatile("" : "+v"(tz));
            for (int it = bx * NTHR + tz; it < moeR * 8192; it += G * NTHR) { const int ut = it >> 13, r = (it >> 5) & 255, ch = it & 31; pg8::Unit u;
                if (!S.locate((long)moeFull + ut, u)) continue;
                if ((u.e >> 8) + r >= u.cnt) continue;
                f32x4 a0 = (f32x4){0.f, 0.f, 0.f, 0.f}, a1 = a0;
                for (int ks = 0; ks < moeS; ++ks) { const u32x4 p = *(const u32x4*)(PB + (((size_t)ks * 128 + ut) * 256 + r) * 256 + ch * 8);
                    a0[0] += bf2f(p.x & 0xffffu); a0[1] += bf2f(p.x >> 16); a0[2] += bf2f(p.y & 0xffffu); a0[3] += bf2f(p.y >> 16); a1[0] += bf2f(p.z & 0xffffu); a1[1] += bf2f(p.z >> 16); a1[2] += bf2f(p.w & 0xffffu); a1[3] += bf2f(p.w >> 16); }
                *(u32x4*)((bf16*)r1 + ((size_t)u.pm * 256 + r) * D + u.pn * 256 + ch * 8) = pack8(a0, a1); }
        }
        if (DBG_CHECK) SEAM(pb + 20);
    }
__global__ void __launch_bounds__(NTHR, 2) fwd_kernel(Args args) {
    extern __shared__ __attribute__((aligned(16))) unsigned char lds_raw[];
    LAS unsigned char* lds = (LAS unsigned char*)lds_raw;
    const int tid = threadIdx.x;
    const int G = gridDim.x, bx = blockIdx.x;
    unsigned char* ws = args.ws;
    volatile LAS unsigned* MISC = (volatile LAS unsigned*)(lds + MISC_OFF);
    if (tid < 256) MISC[tid] = 0u;
    __syncthreads();
    XcdBarrier bar = xcd_barrier_post((unsigned*)(ws + WS_CTL) + CW_BAR, MISC);
    const int lo = args.ph_lo, hi = args.ph_hi;
    bf16* const H = (bf16*)(ws + WS_H); bf16* const XS = (bf16*)(ws + WS_XS); const float* const MOD = (const float*)(ws + WS_MOD);
    unsigned char* const wb = ws + WS_W; unsigned char* const r0 = ws + WS_R0; unsigned char* const r1 = ws + WS_R1;

    if (PHON(0) && IN(0)) { prologue_mod_partial(args, ws, lds, G, bx); }
    SEAM(0);
    if (PHON(0) && IN(1)) { prologue_mod_reduce(args, ws, G, bx); }
    SEAM(1);
    layer_pair<0>(args, ws, lds, G, bx, bar, lo, hi);
    layer_pair<1>(args, ws, lds, G, bx, bar, lo, hi);
    if (PHON(1) && IN(44)) { norm_phase(args, ws, 3, 2, G, bx); }
#undef IN
#undef SEAM
}

#if DBG_CHECK
__device__ __forceinline__ unsigned dh(unsigned x) { x ^= x >> 16; x *= 0x7feb352du; x ^= x >> 15; x *= 0x846ca68bu; x ^= x >> 16; return x; }
__device__ __forceinline__ void rec(unsigned* chk, int ph, float actual, float expect, float flo) {
    float e = fabsf(actual - expect) / (fabsf(expect) + flo); if (!(e == e) || !(fabsf(actual) < 1e30f)) e = 1e30f;
    atomicMax(chk + ph, __float_as_uint(e));
}
__device__ __forceinline__ float ldbf(const bf16* p) { return bf2f(*p); }
__global__ void chk_kernel(Args a, int ph, int pre) {
    unsigned char* ws = a.ws; unsigned* chk = (unsigned*)(ws + WS_CTL) + CW_CHK; float* EX = (float*)(ws + WS_DBG);
    const int i = blockIdx.x * blockDim.x + threadIdx.x; const unsigned r = dh(i * 2654435761u + 12345u + ph * 977u);
    const bf16* H = (const bf16*)(ws + WS_H); const bf16* XS = (const bf16*)(ws + WS_XS); const float* MOD = (const float*)(ws + WS_MOD);
    unsigned char* r0 = ws + WS_R0; unsigned char* r1 = ws + WS_R1;
    const int t = r % T, b = t / LT, s = t % LT, mr = s < CTXL ? 8 : b; const unsigned r2 = dh(r + 77u);
    if (ph == 0) return;
    if (ph == 1) { if (pre) return; const int l = r2 & 3, rr = (r2 >> 2) % 9, n = (r2 >> 8) % 6144; float acc = a.in[LIN(l, 1)][n];
        for (int k = 0; k < 1024; ++k) { const float c = rr < 8 ? a.in[IN_C][rr * 1024 + k] : a.in[IN_CCTX][k]; acc += c / (1.f + expf(-c)) * a.in[LIN(l, 0)][(size_t)k * 6144 + n]; }
        rec(chk, ph, MOD[((size_t)l * 9 + rr) * 6144 + n], acc, 0.02f); return; }
    if (ph == NPH - 1) { if (pre) return; if (s < CTXL) return; const int c = r2 & 1023; const bf16* row; float ss = 0.f;
        const int4 tk = *(const int4*)(ws + WS_TOK + (size_t)t * 16); const unsigned* cw = (const unsigned*)(ws + WS_CTL) + CW_CNT + 1 * 8 * 64; int tb0 = 0, tb1 = 0, accT = 0;
        for (int e = 0; e < 8; ++e) { if (e == tk.x) tb0 = accT; if (e == tk.z) tb1 = accT; accT += ((int)cw[e * 64] + 255) >> 8; }
        const bf16* y0 = (const bf16*)r1 + ((size_t)tb0 * 256 + tk.y) * D, *y1 = (const bf16*)r1 + ((size_t)tb1 * 256 + tk.w) * D; row = XS + (size_t)t * D; float xc = 0.f;
        for (int k = 0; k < 1024; ++k) { const float v = ldbf(row + k) + MOD[((size_t)3 * 9 + mr) * 6144 + 5 * 1024 + k] * (ldbf(y0 + k) + ldbf(y1 + k)); ss += v * v; if (k == c) xc = v; }
        rec(chk, ph, a.out[((size_t)b * SEQ + (s - CTXL)) * D + c], xc * rsqrtf(ss / 1024.f + NORM_EPS) * a.in[IN_FINAL][c], 0.3f); return; }
    const int q0 = (ph - 2) % 21, q = q0 <= 16 ? q0 : q0 - 1, lp = (ph - 2) / 21, le = 2 * lp, lo = 2 * lp + 1;
    if (q0 == 17) return;
    if (q == 0 || q == 6 || q == 9 || q == 16) {
        if (pre) return; const int layer = (q == 0 || q == 6) ? le : lo, which = (q == 0 || q == 9) ? 0 : 1; const int c = r2 & 1023;
        const bf16* row = XS + (size_t)t * D; float ss = 0.f;
        for (int k = 0; k < 1024; ++k) ss += ldbf(row + k) * ldbf(row + k);
        const float* g = a.in[LIN(layer, which == 0 ? 2 : ((layer & 1) ? 9 : 10))]; const float* m = MOD + ((size_t)layer * 9 + mr) * 6144 + (which ? 3 * 1024 : 0);
        const float e = ldbf(row + c) * rsqrtf(ss / 1024.f + NORM_EPS) * g[c] * (1.f + m[1024 + c]) + m[c];
        rec(chk, ph, ldbf(H + (size_t)t * D + c), e, 0.3f);
        if (layer == 0 && which == 0) { const float xin = s < CTXL ? a.in[IN_CTX][((size_t)b * CTXL + s) * D + c] : a.in[IN_X][((size_t)b * SEQ + (s - CTXL)) * D + c]; rec(chk, ph, ldbf(row + c), xin, 0.05f); }
        return; }
    if (q == 1) { if (pre) return; const int c = r2 % EVEN_IN; float acc = 0.f; for (int k = 0; k < 1024; ++k) acc += ldbf(H + (size_t)t * D + k) * a.in[LIN(le, 3)][(size_t)k * EVEN_IN + c];
        rec(chk, ph, ldbf((const bf16*)(r0 + RE_P) + (size_t)t * EVEN_INP + c), acc, 0.3f); return; }
    if (q == 2) { if (pre) return; const bf16* P = (const bf16*)(r0 + RE_P); const int c = r2 & 511; const bool hp = (s != 0 && s != CTXL), hn = (s != CTXL - 1 && s != LT - 1);
        const float* cw = a.in[LIN(le, 4)]; const bf16* pr = P + (size_t)t * EVEN_INP; float y = cw[512 + c] * ldbf(pr + 512 + c) * ldbf(pr + 1024 + c);
        if (hp) y += cw[c] * ldbf(pr - EVEN_INP + 512 + c) * ldbf(pr - EVEN_INP + 1024 + c); if (hn) y += cw[1024 + c] * ldbf(pr + EVEN_INP + 512 + c) * ldbf(pr + EVEN_INP + 1024 + c);
        rec(chk, ph, ldbf((const bf16*)(r0 + RE_MIX) + (size_t)t * D + c), ldbf(pr + c) * y, 0.2f);
        { const int cc = r2 % 384; float ss = 0.f; const int base = cc < 256 ? 1536 : 1792, n = cc < 256 ? 256 : 128, ci = cc < 256 ? cc : cc - 256; for (int k = 0; k < n; ++k) { const float v = ldbf(pr + base + k); ss += v * v; }
          const float g = cc < 256 ? a.in[LIN(le, 5)][ci] : a.in[LIN(le, 7)][ci]; rec(chk, ph, ldbf((const bf16*)(r0 + RE_A2) + (size_t)t * UP_K + cc), ldbf(pr + base + ci) * rsqrtf(ss / n + NORM_EPS) * g, 0.2f); }
        { const int o = r2 & 31; const bf16* xr = pr + 1920;
          float outv = ldbf(xr + o);
          if (s >= CTXL) { const int pos = s - CTXL, seg = o >> 3, j = o & 7; const int ai = (seg < 2) ? j : 8 + j; const float rc = (seg < 2) ? (float)(pos >> 6) : (float)(pos & 63);
              const float ang = rc * powf(10000.f, -(float)j / 8.f), cs = cosf(ang), sn = sinf(ang); const float av = (seg < 2) ? ldbf(xr + j) : ldbf(xr + 16 + j), bv = (seg < 2) ? ldbf(xr + 8 + j) : ldbf(xr + 24 + j);
              outv = (seg == 0 || seg == 2) ? av * cs - bv * sn : bv * cs + av * sn; (void)ai; }
          const int seg = o >> 3, j = o & 7, ii = (seg < 2) ? j : 8 + j, ab = seg & 1; rec(chk, ph, ldbf((const bf16*)(ws + WS_KR) + (size_t)t * 32 + 2 * ii + ab), outv, 0.2f); }
        return; }
    if (q == 3) { if (pre) return; const bf16* A2 = (const bf16*)(r0 + RE_A2) + (size_t)t * UP_K; const int h = r2 & 7;
        { const int o = (r2 >> 3) % 96; float v; auto qdot = [&](int col) { float acc = 0.f; for (int k = 0; k < 256; ++k) acc += ldbf(A2 + k) * a.in[LIN(le, 6)][(size_t)k * 768 + col]; return acc; };
          int ipos;
          if (o < 64) { v = qdot(h * 96 + o); ipos = o; }
          else { const int oo = o - 64, seg = oo >> 3, j = oo & 7; const float av = qdot(h * 96 + 64 + ((seg < 2) ? j : 16 + j)), bv = qdot(h * 96 + 64 + ((seg < 2) ? 8 + j : 24 + j));
              if (s >= CTXL) { const int pos = s - CTXL; const float rc = (seg < 2) ? (float)(pos >> 6) : (float)(pos & 63), ang = rc * powf(10000.f, -(float)j / 8.f), cs = cosf(ang), sn = sinf(ang);
                  v = (seg == 0 || seg == 2) ? av * cs - bv * sn : bv * cs + av * sn; } else v = (seg == 0 || seg == 2) ? av : bv;
              ipos = 64 + 2 * ((seg < 2) ? j : 8 + j) + (seg & 1); }
          rec(chk, ph, ldbf((const bf16*)(r0 + RE_Q) + (size_t)t * 768 + h * 96 + ipos), v * QSCALE, 0.05f); }
        { const int o = (r2 >> 12) & 127; float acc = 0.f; for (int k = 0; k < 128; ++k) acc += ldbf(A2 + 256 + k) * a.in[LIN(le, 8)][(size_t)k * 1024 + h * 128 + o];
          const float got = o < 64 ? ldbf((const bf16*)(r0 + RE_KN) + (size_t)t * 512 + h * 64 + o) : ldbf((const bf16*)(r0 + RE_VT) + ((size_t)(b * 8 + h) * 64 + (o - 64)) * LT + s);
          rec(chk, ph, got, acc, 0.3f); }
        return; }
    if (q == 4) { if (pre) return; if (i >= 2048) return; const int h = r2 & 7, dv = (r2 >> 3) & 63; const bf16* Q = (const bf16*)(r0 + RE_Q) + (size_t)t * 768 + h * 96;
        const int nk = s < CTXL ? CTXL : LT; float mx = -3e38f;
        for (int pass = 0; pass < 2; ++pass) { float l = 0.f, o = 0.f;
            for (int k = 0; k < nk; ++k) { const size_t tk = (size_t)b * LT + k; float sc = 0.f; for (int d = 0; d < 64; ++d) sc += ldbf(Q + d) * ldbf((const bf16*)(r0 + RE_KN) + tk * 512 + h * 64 + d);
                for (int d = 0; d < 32; ++d) sc += ldbf(Q + 64 + d) * ldbf((const bf16*)(ws + WS_KR) + tk * 32 + d);
                if (pass == 0) mx = fmaxf(mx, sc); else { const float p = exp2f(sc - mx); l += p; o += p * ldbf((const bf16*)(r0 + RE_VT) + ((size_t)(b * 8 + h) * 64 + dv) * LT + k); } }
            if (pass == 1) rec(chk, ph, ldbf((const bf16*)(r0 + RE_MIX) + (size_t)t * D + 512 + h * 64 + dv), o / l, 0.1f); }
        return; }
    if (q == 5 || q == 8 || q == 15) {
        const int c = r2 & 1023; const bf16* A; const float* W; int K; const float* gate;
        if (q == 5) { A = (const bf16*)(r0 + RE_MIX) + (size_t)t * D; W = a.in[LIN(le, 9)]; K = 1024; gate = MOD + ((size_t)le * 9 + mr) * 6144 + 2 * 1024; }
        else if (q == 8) { A = (const bf16*)(r0 + RE_ACT) + (size_t)t * FFN_F; W = a.in[LIN(le, 12)]; K = FFN_F; gate = MOD + ((size_t)le * 9 + mr) * 6144 + 5 * 1024; }
        else { A = (const bf16*)r1 + (size_t)2 * T * D + (size_t)t * D; W = a.in[LIN(lo, 8)]; K = 1024; gate = MOD + ((size_t)lo * 9 + mr) * 6144 + 2 * 1024; }
        if (pre) { float acc = 0.f; for (int k = 0; k < K; ++k) acc += ldbf(A + k) * W[(size_t)k * 1024 + c]; EX[i] = ldbf(XS + (size_t)t * D + c) + gate[c] * acc; }
        else rec(chk, ph, ldbf(XS + (size_t)t * D + c), EX[i], 0.3f);
        return; }
    if (q == 7) { if (pre) return; const int c = r2 % FFN_F; float g = 0.f, u = 0.f; for (int k = 0; k < 1024; ++k) { const float hv = ldbf(H + (size_t)t * D + k); g += hv * a.in[LIN(le, 11)][(size_t)k * 2 * FFN_F + c]; u += hv * a.in[LIN(le, 11)][(size_t)k * 2 * FFN_F + FFN_F + c]; }
        rec(chk, ph, ldbf((const bf16*)(r0 + RE_ACT) + (size_t)t * FFN_F + c), g / (1.f + expf(-g)) * u, 0.2f); return; }
    if (q == 10) { if (pre) return; const int c = r2 % ODD_IN; float acc = 0.f; for (int k = 0; k < 1024; ++k) acc += ldbf(H + (size_t)t * D + k) * a.in[LIN(lo, 3)][(size_t)k * ODD_IN + c];
        const float got = c < 3072 ? ldbf((const bf16*)r0 + (size_t)t * 3072 + c) : (c < 4096 ? ldbf((const bf16*)(ws + WS_R2) + (size_t)t * 1024 + (c - 3072)) : ((const float*)(ws + WS_AB))[(size_t)t * 32 + (c - 4096)]);
        rec(chk, ph, got, acc, 0.3f); return; }
    if (q == 11) { if (pre) return; const bf16* QR = (const bf16*)r0; const int g = r2 % 3, h = (r2 >> 4) & 7, d = (r2 >> 8) & 127; const bool hp = (s != 0 && s != CTXL), hn = (s != CTXL - 1 && s != LT - 1);
        const float* cw = a.in[LIN(lo, 4)]; float ss = 0.f, mine = 0.f;
        for (int k = 0; k < 128; ++k) { const int c = g * 1024 + h * 128 + k; float y = cw[3072 + c] * ldbf(QR + (size_t)t * 3072 + c); if (hp) y += cw[c] * ldbf(QR + (size_t)(t - 1) * 3072 + c); if (hn) y += cw[6144 + c] * ldbf(QR + (size_t)(t + 1) * 3072 + c);
            const float v = y / (1.f + expf(-y)); ss += v * v; if (k == d) mine = v; }
        const float e = g == 2 ? mine : mine * rsqrtf(ss + NORM_EPS) * (g == 0 ? 0.08838834764831845f : 1.f);
        rec(chk, ph, ldbf((const bf16*)r1 + (size_t)t * 3072 + g * 1024 + h * 128 + d), e, g == 2 ? 0.05f : 0.005f);
        { const int idx = r2 & 15; const float av = ((const float*)(ws + WS_AB))[(size_t)t * 32 + idx], bt = ((const float*)(ws + WS_AB))[(size_t)t * 32 + 16 + idx]; const float z = av + a.in[LIN(lo, 6)][idx];
          rec(chk, ph, ((const float*)(ws + WS_GB))[(size_t)t * 32 + idx], -expf(a.in[LIN(lo, 5)][idx]) * (z > 20.f ? z : log1pf(expf(z))), 1e-3f); rec(chk, ph, ((const float*)(ws + WS_GB))[(size_t)t * 32 + 16 + idx], 1.f / (1.f + expf(-bt)), 1e-2f); }
        return; }
    if (q == 12) return;
    if (q == 13) {
        if (pre) return; if (blockIdx.x >= 6) return; const int dv = threadIdx.x; if (dv >= 128) return;
        const int cb = (blockIdx.x * 3) & 7, chh = (blockIdx.x * 5 + 1) & 7, dir = blockIdx.x & 1; const bf16* QN = (const bf16*)r1; const float* GB = (const float*)(ws + WS_GB);
        return; }
    if (q == 14) { if (pre) return; const int c = r2 & 1023, h = c >> 7; const bf16* OF = (const bf16*)r1 + (size_t)t * D, *OB = OF + (size_t)T * D; float ss = 0.f;
        for (int k = 0; k < 128; ++k) { const float v = ldbf(OF + h * 128 + k) + ldbf(OB + h * 128 + k); ss += v * v; }
        const float o = ldbf(OF + c) + ldbf(OB + c), gt = ldbf((const bf16*)(ws + WS_R2) + (size_t)t * D + c);
        rec(chk, ph, ldbf((const bf16*)r1 + (size_t)2 * T * D + (size_t)t * D + c), o * rsqrtf(ss / 128.f + NORM_EPS) * a.in[LIN(lo, 7)][c & 127] * (gt / (1.f + expf(-gt))), 0.1f); return; }
    if (q == 17 || q == 18) { if (pre) return; const unsigned* cw = (const unsigned*)(ws + WS_CTL) + CW_CNT + lp * 8 * 64; const int e = r2 & 7; int tb = 0; for (int k = 0; k < e; ++k) tb += ((int)cw[k * 64] + 255) >> 8;
        const int cnt = (int)cw[e * 64]; if (cnt == 0) return; const int pos = (r2 >> 3) % cnt; const int tok = ((const int*)(ws + WS_LIST))[(size_t)e * T + pos]; const size_t slot = (size_t)tb * 256 + pos;
        if (q == 17) { const int c = (r2 >> 16) % MOE_F; const float* W = a.in[LIN(lo, 11)] + (size_t)e * D * 2 * MOE_F; float g = 0.f, u = 0.f;
            for (int k = 0; k < 1024; ++k) { const float hv = ldbf(H + (size_t)tok * D + k); g += hv * W[(size_t)k * 2 * MOE_F + c]; u += hv * W[(size_t)k * 2 * MOE_F + MOE_F + c]; }
            rec(chk, ph, ldbf((const bf16*)r0 + slot * MOE_F + c), g / (1.f + expf(-g)) * u, 0.2f); }
        else { const int c = (r2 >> 16) & 1023; const float* W = a.in[LIN(lo, 12)] + (size_t)e * MOE_F * D; float acc = 0.f; for (int k = 0; k < MOE_F; ++k) acc += ldbf((const bf16*)r0 + slot * MOE_F + k) * W[(size_t)k * D + c];
            rec(chk, ph, ldbf((const bf16*)r1 + slot * D + c), acc * ((const float*)(ws + WS_GW))[(size_t)e * T + pos], 0.2f); }
        return; }
}
__global__ void __launch_bounds__(128) chk_gdn_ref(Args a, int lp) {
    unsigned char* ws = a.ws; float* EX = (float*)(ws + WS_END); const bf16* QN = (const bf16*)(ws + WS_R1); const float* GB = (const float*)(ws + WS_GB);
    const int j = blockIdx.x, b = (j * 3) & 7, h = (j * 5 + 1) & 7, dir = j & 1, dv = threadIdx.x; (void)lp;
    float S[128];
#pragma unroll
    for (int k = 0; k < 128; ++k) S[k] = 0.f;
    __shared__ float kq[256];
    for (int n = 0; n < LT; ++n) { const int s = dir ? (n < CTXL ? CTXL - 1 - n : LT - 1 - (n - CTXL)) : n; const size_t t = (size_t)b * LT + s;
        __syncthreads(); kq[dv] = ldbf(QN + t * 3072 + 1024 + h * 128 + dv); kq[128 + dv] = ldbf(QN + t * 3072 + h * 128 + dv); __syncthreads();
        const float g = GB[t * 32 + dir * 8 + h], beta = GB[t * 32 + 16 + dir * 8 + h], al = expf(g), v = ldbf(QN + t * 3072 + 2048 + h * 128 + dv);
        float ks = 0.f;
#pragma unroll
        for (int k = 0; k < 128; ++k) ks += kq[k] * S[k];
        float o = 0.f;
#pragma unroll
        for (int k = 0; k < 128; ++k) { S[k] = al * (S[k] - beta * kq[k] * ks) + beta * kq[k] * v; o += kq[128 + k] * S[k]; }
        EX[((size_t)j * LT + s) * 128 + dv] = o; }
}
__global__ void __launch_bounds__(128) chk_gdn_chunk(Args a, int ph) {
    unsigned char* ws = a.ws; unsigned* chk = (unsigned*)(ws + WS_CTL) + CW_CHK; const bf16* QN = (const bf16*)(ws + WS_R1); const float* GB = (const float*)(ws + WS_GB);
    __shared__ float gc[64], bt[64], Lm[64][65], xs[128][65];
    const unsigned r = dh(blockIdx.x * 7919u + 17u); const int b = r & 7, h = (r >> 3) & 7, dir = blockIdx.x & 1, blk = (r >> 8) % 36, tid = threadIdx.x;
    const size_t t0 = (size_t)b * LT + blk * 64; const unsigned char* cl = ws + WS_R0 + (size_t)(((b * 8 + h) * 2 + dir) * 36 + blk) * CL_BYTES;
#define TOK(i) (t0 + (dir ? 63 - (i) : (i)))
    if (tid == 0) { float acc = 0.f; for (int i = 0; i < 64; ++i) { acc += GB[TOK(i) * 32 + dir * 8 + h]; gc[i] = acc; bt[i] = GB[TOK(i) * 32 + 16 + dir * 8 + h]; } }
    __syncthreads();
    for (int e = tid; e < 4096; e += 128) { const int i = e >> 6, j = e & 63; float d = 0.f; for (int k = 0; k < 128; ++k) d += ldbf(QN + TOK(i) * 3072 + 1024 + h * 128 + k) * ldbf(QN + TOK(j) * 3072 + 1024 + h * 128 + k);
        Lm[i][j] = j < i ? bt[i] * d * expf(gc[i] - gc[j]) : 0.f; }
    __syncthreads();
    const bool isW = tid >= 64; const int col = isW ? 2 * (tid - 64) + 1 : 2 * tid;
    for (int i = 0; i < 64; ++i) { float x = isW ? ldbf(QN + TOK(i) * 3072 + 1024 + h * 128 + col) * bt[i] * expf(gc[i]) : ldbf(QN + TOK(i) * 3072 + 2048 + h * 128 + col) * bt[i];
        for (int j = 0; j < i; ++j) x -= Lm[i][j] * xs[tid][j];
        xs[tid][i] = x;
        float got;
        if (!isW) got = ldbf((const bf16*)(cl + CL_UT + (size_t)(((col >> 4) * 4 + (i >> 4)) * 64 + ((i & 15) >> 2) * 16 + (col & 15)) * 8 + (i & 3) * 2));
        else got = ldbf((const bf16*)(cl + CL_W + (size_t)(((i >> 4) * 4 + (col >> 5)) * 64 + ((col & 15) >> 2) * 16 + (i & 15)) * 16 + (4 * ((col & 31) >> 4) + (col & 3)) * 2));
        rec(chk, ph, got, x, 0.05f);
    }
    for (int e = tid; e < 2048; e += 128) { const unsigned rr = dh(e * 31u + blockIdx.x); const int i = rr & 63, dk = (rr >> 6) & 127, j = (rr >> 13) & 63;
        { const float ex = ldbf(QN + TOK(i) * 3072 + h * 128 + dk) * expf(gc[i]);
          rec(chk, ph, ldbf((const bf16*)(cl + CL_QG + (size_t)(((i >> 4) * 4 + (dk >> 5)) * 64 + ((dk & 15) >> 2) * 16 + (i & 15)) * 16 + (4 * ((dk & 31) >> 4) + (dk & 3)) * 2)), ex, 0.01f); }
        { const float ex = ldbf(QN + TOK(i) * 3072 + 1024 + h * 128 + dk) * expf(gc[63] - gc[i]);
          rec(chk, ph, ldbf((const bf16*)(cl + CL_KDT + (size_t)(((dk >> 4) * 2 + (i >> 5)) * 64 + ((i & 15) >> 2) * 16 + (dk & 15)) * 16 + (4 * ((i & 31) >> 4) + (i & 3)) * 2)), ex, 0.02f); }
        { float d = 0.f; for (int k = 0; k < 128; ++k) d += ldbf(QN + TOK(i) * 3072 + h * 128 + k) * ldbf(QN + TOK(j) * 3072 + 1024 + h * 128 + k);
          const float ex = j <= i ? d * expf(gc[i] - gc[j]) : 0.f;
          rec(chk, ph, ldbf((const bf16*)(cl + CL_ATT + (size_t)(((i >> 4) * 2 + (j >> 5)) * 64 + ((j & 15) >> 2) * 16 + (i & 15)) * 16 + (4 * ((j & 31) >> 4) + (j & 3)) * 2)), ex, 0.01f); }
    }
    if (tid == 0) rec(chk, ph, ((const float*)(ws + WS_GEND))[((b * 8 + h) * 2 + dir) * 36 + blk], expf(gc[63]), 0.01f);
#undef TOK
}
__global__ void chk_gdn_cmp(Args a, int ph) {
    unsigned char* ws = a.ws; unsigned* chk = (unsigned*)(ws + WS_CTL) + CW_CHK; const float* EX = (const float*)(ws + WS_END);
    const int j = blockIdx.x, b = (j * 3) & 7, h = (j * 5 + 1) & 7, dir = j & 1, dv = threadIdx.x; const bf16* OX = (const bf16*)(ws + WS_R1) + (size_t)dir * T * D;
    for (int s = 0; s < LT; ++s) rec(chk, ph, ldbf(OX + ((size_t)b * LT + s) * D + h * 128 + dv), EX[((size_t)j * LT + s) * 128 + dv], 0.1f);
}
__global__ void chk_report(Args a) {
    const unsigned* chk = (const unsigned*)(a.ws + WS_CTL) + CW_CHK; int bad = -1;
    for (int k = 0; k < NPH; ++k) if (__uint_as_float(chk[k]) > 0.1f) { bad = k; break; }
    if (bad < 0) return;
    const float c = exp2f((float)(bad + 1));
    for (size_t i = (size_t)blockIdx.x * blockDim.x + threadIdx.x; i < (size_t)NB * SEQ * D; i += (size_t)gridDim.x * blockDim.x) a.out[i] = c;
}
#endif

extern "C" void kernel_launch(void* const* d_in, const int* in_sizes, int n_in, void* d_out, int out_size, void* d_ws, size_t ws_size, hipStream_t stream) {
    static int grid = 0;
    if (grid == 0) {
        if (n_in != 57 || in_sizes[0] != NB * SEQ * D || out_size != NB * SEQ * D || ws_size < WS_END + 64 * MiB) { fprintf(stderr, "kernel_launch: unexpected shapes (n_in %d, in0 %d, out %d, ws %zu < %zu)\n", n_in, n_in > 0 ? in_sizes[0] : -1, out_size, ws_size, (size_t)WS_END); grid = -1; return; }
        int dev = 0, cus = 0, per_cu = 0;
        if (hipGetDevice(&dev) != hipSuccess || hipDeviceGetAttribute(&cus, hipDeviceAttributeMultiprocessorCount, dev) != hipSuccess) { grid = -1; return; }
        if (hipFuncSetAttribute((const void*)fwd_kernel, hipFuncAttributeMaxDynamicSharedMemorySize, LDS_BYTES) != hipSuccess) { fprintf(stderr, "kernel_launch: hipFuncSetAttribute failed\n"); grid = -1; return; }
        if (hipOccupancyMaxActiveBlocksPerMultiprocessor(&per_cu, (const void*)fwd_kernel, NTHR, LDS_BYTES) != hipSuccess || per_cu < 1) fprintf(stderr, "kernel_launch: occupancy query says %d\n", per_cu);
        (void)hipGetLastError();
        grid = cus;
    }
    if (grid < 0) return;
    (void)hipMemsetAsync((char*)d_ws + WS_CTL, 0, CTL_ZERO_BYTES, stream);
    Args a{};
    for (int i = 0; i < 57; ++i) a.in[i] = (const float*)d_in[i];
    a.out = (float*)d_out; a.ws = (unsigned char*)d_ws;
#if N_LAUNCH_MODE == 1
    a.ph_lo = 0; a.ph_hi = NPH;
    hipLaunchKernelGGL(fwd_kernel, dim3(grid), dim3(NTHR), LDS_BYTES, stream, a);
#else
    for (int k = 0; k < NPH; ++k) { a.ph_lo = k; a.ph_hi = k + 1;
#if DBG_CHECK
        hipLaunchKernelGGL(chk_kernel, dim3(64), dim3(256), 0, stream, a, k, 1);
#endif
        hipLaunchKernelGGL(fwd_kernel, dim3(grid), dim3(NTHR), LDS_BYTES, stream, a);
#if DBG_CHECK
        hipLaunchKernelGGL(chk_kernel, dim3(64), dim3(256), 0, stream, a, k, 0);
        if (k >= 2 && k < NPH - 1 && (k - 2) % 21 == 12) { hipLaunchKernelGGL(chk_gdn_chunk, dim3(16), dim3(128), 0, stream, a, k); hipLaunchKernelGGL(chk_gdn_ref, dim3(6), dim3(128), 0, stream, a, (k - 2) / 21); }
        if (k >= 2 && k < NPH - 1 && (k - 2) % 21 == 13) hipLaunchKernelGGL(chk_gdn_cmp, dim3(6), dim3(128), 0, stream, a, k);
#endif
    }
#if DBG_CHECK
    hipLaunchKernelGGL(chk_report, dim3(256), dim3(256), 0, stream, a);
#endif
#endif
}
```

```cpp
#include <hip/hip_runtime.h>
#include <cstdio>
#include <cstdint>

#ifndef N_LAUNCH_MODE
#define N_LAUNCH_MODE 1
#endif
#ifndef DBG_CHECK
#define DBG_CHECK 0
#endif

#define LAS __attribute__((address_space(3)))
#define GAS __attribute__((address_space(1)))
typedef unsigned short bf16;
typedef short bf16x8 __attribute__((ext_vector_type(8)));
typedef short s16x4 __attribute__((ext_vector_type(4)));
typedef float f32x4 __attribute__((ext_vector_type(4)));
typedef float f32x2 __attribute__((ext_vector_type(2)));
typedef unsigned u32x4 __attribute__((ext_vector_type(4)));
typedef unsigned u32x2 __attribute__((ext_vector_type(2)));
#define DI __device__ __forceinline__

constexpr int D = 1024, NB = 8, SEQ = 2048, CTXL = 256, LT = SEQ + CTXL  , T = NB * LT  ;
constexpr float NORM_EPS = 1e-6f;
constexpr int EVEN_IN = 1952, EVEN_INP = 2048, UP_K = 384, UP_N = 1792, FFN_F = 2816;
constexpr int ODD_IN = 4128, ODD_INP = 4352, MOE_F = 3584, NEXP = 8;
constexpr int MOE_ROWS = 2 * T + NEXP * 256;
constexpr int NWAVES = 8, NTHR = 512;
constexpr float QSCALE = 0.10206207261596575f * 1.4426950408889634f;

constexpr int IN_X = 0, IN_C = 1, IN_CTX = 2, IN_CCTX = 3, IN_FINAL = 56;
#define LIN(l, j) (4 + 13 * (l) + (j))

constexpr size_t MiB = 1u << 20;
constexpr size_t WS_CTL = 0, CTL_ZERO_BYTES = 1 * MiB;
constexpr size_t WS_MOD = 1 * MiB;
constexpr size_t WS_ROPE = 2 * MiB;
constexpr size_t WS_TOK = 3 * MiB;
constexpr size_t WS_LIST = 4 * MiB;
constexpr size_t WS_GW = 5 * MiB;
constexpr size_t WS_AB = 6 * MiB;
constexpr size_t WS_GB = 9 * MiB;
constexpr size_t WS_GEND = 12 * MiB;
constexpr size_t WS_KR = 13 * MiB;
constexpr size_t WS_DBG = 15 * MiB;
constexpr size_t WS_XS = 16 * MiB;
constexpr size_t WS_H = 88 * MiB;
constexpr size_t WS_W = 124 * MiB;
constexpr size_t WS_WO = 149 * MiB;
constexpr size_t WS_R0 = 328 * MiB;
constexpr size_t WS_R1 = 652 * MiB;
constexpr size_t WS_R2 = 760 * MiB;
constexpr size_t WS_END = 796 * MiB;
constexpr size_t WE_IN = 0, WE_UP = 4 * MiB, WE_OUT = 6 * MiB, WE_W1 = 8 * MiB, WE_W2 = 19 * MiB;
constexpr size_t WO_IN = 0, WO_OUT = 9 * MiB, WO_W1 = 11 * MiB, WO_W2 = 123 * MiB;
constexpr size_t RE_P = 0, RE_MIX = 72 * MiB, RE_A2 = 108 * MiB, RE_Q = 122 * MiB, RE_KN = 149 * MiB, RE_VT = 167 * MiB, RE_ACT = 185 * MiB;
constexpr size_t CL_BYTES = 73728;
constexpr size_t CL_W = 0, CL_QG = 16384, CL_KDT = 32768, CL_ATT = 49152, CL_UT = 57344;
constexpr int CW_TMO = 0, CW_BAR = 4096, CW_CNT = 8192  , CW_CHK = 12288, CW_WGSUM = 16384  , CW_WCNT = 32768  ;

DI float bf2f(unsigned v) { return __uint_as_float(v << 16); }
typedef __bf16 bf16x2_t __attribute__((ext_vector_type(2)));
DI unsigned cvt_pk_bf16(float lo, float hi) { const f32x2 v = {lo, hi}; const bf16x2_t b = __builtin_convertvector(v, bf16x2_t); return __builtin_bit_cast(unsigned, b); }
DI unsigned f2bf(float f) { return cvt_pk_bf16(f, 0.f) & 0xffffu; }
template <int CTRL> DI float dpp_f(float v) { return __builtin_bit_cast(float, __builtin_amdgcn_update_dpp(0, __builtin_bit_cast(int, v), CTRL, 0xf, 0xf, true)); }
template <int CTRL> DI unsigned dpp_u(unsigned v) { return (unsigned)__builtin_amdgcn_update_dpp(0, (int)v, CTRL, 0xf, 0xf, true); }
DI float sum8(float v) { v += dpp_f<0xB1>(v); v += dpp_f<0x4E>(v); v += dpp_f<0x141>(v); return v; }
DI float sum16(float v) { v = sum8(v); v += dpp_f<0x140>(v); return v; }
DI float wave_sum(float v) {
    v = sum16(v);
    { const auto r = __builtin_amdgcn_permlane16_swap(__float_as_uint(v), __float_as_uint(v), false, false); v = __uint_as_float(r[0]) + __uint_as_float(r[1]); }
    { const auto r = __builtin_amdgcn_permlane32_swap(__float_as_uint(v), __float_as_uint(v), false, false); v = __uint_as_float(r[0]) + __uint_as_float(r[1]); }
    return v;
}
DI float wave_scan_incl(float v) {
    v += dpp_f<0x111>(v); v += dpp_f<0x112>(v); v += dpp_f<0x114>(v); v += dpp_f<0x118>(v);
    v += __builtin_bit_cast(float, __builtin_amdgcn_update_dpp(0, __builtin_bit_cast(int, v), 0x142, 0xa, 0xf, false));
    v += __builtin_bit_cast(float, __builtin_amdgcn_update_dpp(0, __builtin_bit_cast(int, v), 0x143, 0xc, 0xf, false));
    return v;
}
DI unsigned wave_sum_u(unsigned v) {
    v += dpp_u<0xB1>(v); v += dpp_u<0x4E>(v); v += dpp_u<0x141>(v); v += dpp_u<0x140>(v);
    { const auto r = __builtin_amdgcn_permlane16_swap(v, v, false, false); v = r[0] + r[1]; }
    { const auto r = __builtin_amdgcn_permlane32_swap(v, v, false, false); v = r[0] + r[1]; }
    return v;
}
DI float silu_f(float x) { return x * __builtin_amdgcn_rcpf(1.f + __expf(-x)); }
#define LDS_WAIT() asm volatile("s_waitcnt lgkmcnt(0)" ::: "memory")
#define VM_WAIT() asm volatile("s_waitcnt vmcnt(0)" ::: "memory")

namespace pg8 {
constexpr int BM = 256, BK = 64, HALF = 128, HTB = HALF * BK * 2, STAGE_BYTES = 8 * HTB, NXCD = 8, WGM = 8;
__host__ __device__ __forceinline__ int lds_byte(int r, int c) { const int st = (r >> 4) * 2 + (c >> 5), rr = r & 15, cc = c & 31, ob = rr * 64 + cc * 2; return st * 1024 + (ob ^ (((ob >> 9) & 1) << 5)); }
__host__ __device__ __forceinline__ void stage_rc(int b, int& R, int& C) { const int st = b / 1024, sb = b % 1024, swz = sb ^ (((sb >> 9) & 1) << 5); R = (st >> 1) * 16 + swz / 64; C = (st & 1) * 32 + (swz % 64) / 2; }
__host__ __device__ __forceinline__ int perm32(int rho) { const int n = rho >> 4, i = rho & 15; return 8 * (i >> 2) + 4 * n + (i & 3); }

struct Unit { int pm, pn, e, cnt, aux; };

struct DenseOrder {
    static constexpr bool GATHER = false;
    const bf16* A; const bf16* Bt; int lda, ldb;
    int nM, nN, nwg, G, c, skipctx;
    DI void init(const bf16* A_, int lda_, const bf16* Bt_, int ldb_, int M, int N, int G_, int c_, int skipctx_ = 0) { A = A_; Bt = Bt_; lda = lda_; ldb = ldb_; nM = M / BM; nN = N / BM; skipctx = skipctx_; if (skipctx) nM = nM / 9 * 8; nwg = nM * nN; G = G_; c = c_; }
    DI bool next(int i, Unit& u) const {
        const long L = (long)i * G + c; if (L >= nwg) return false;
        int wgid = (int)L; { const int q = nwg / NXCD, r = nwg % NXCD, xcd = wgid % NXCD, off = wgid / NXCD; wgid = (xcd < r ? xcd * (q + 1) : r * (q + 1) + (xcd - r) * q) + off; }
        const int nig = WGM * nN, gid = wgid / nig, fm = gid * WGM, gsz = (nM - fm) < WGM ? (nM - fm) : WGM;
        u.pm = fm + ((wgid % nig) % gsz); u.pn = (wgid % nig) / gsz; u.e = 0; u.cnt = 256;
        if (skipctx) u.pm = (u.pm >> 3) * 9 + 1 + (u.pm & 7);
        return true;
    }
    DI const char* abase(const Unit& u) const { return (const char*)A + (size_t)u.pm * 256 * lda * 2; }
    DI const char* bbase(const Unit& u) const { return (const char*)Bt + (size_t)u.pn * 256 * ldb * 2; }
    DI unsigned arow(const Unit&, int) const { return 0u; }
};

template <class Epi, class Sched, int K, int lda, int ldb, bool ALIGN_EPI = true, bool SP2 = true>
__device__ __forceinline__ void gemm_phase(LAS unsigned char* lds, const Sched& S, const Epi& E) {
    int tid = threadIdx.x; asm volatile("" : "+v"(tid));
    const int wid = __builtin_amdgcn_readfirstlane(tid >> 6), lane = tid & 63, wr = wid >> 2, wc = wid & 3, fr = lane & 15, fq = lane >> 4;
    constexpr int nt = K / BK;
    unsigned voffA[2], voffB[2]; int RA[2], CA[2];
#pragma unroll
    for (int i = 0; i < 2; ++i) { int R, C; stage_rc(tid * 16 + i * 8192, R, C); const int Rb = Epi::PERM ? ((R & ~31) + perm32(R & 31)) : R;
        RA[i] = R; CA[i] = C; voffA[i] = (unsigned)(R * lda + C) * 2u; voffB[i] = (unsigned)(Rb * ldb + C) * 2u; }
    const size_t kstep = (size_t)(BK * 2);
    const size_t hstepA = (size_t)HALF * lda * 2, hstepB = (size_t)HALF * ldb * 2;
    const unsigned ldsw = (unsigned)wid * 1024u;
    const int aoff = lds_byte(wr * 64 + fr, fq * 8), boff = lds_byte(wc * 32 + fr, fq * 8);
#define PG8_SA(b, h) (((b) * 2 + (h)) * HTB)
#define PG8_SB(b, h) ((4 + (b) * 2 + (h)) * HTB)
#define PG8_STAGE(bufoff, gbase, voff) do { _Pragma("unroll") for (int _i = 0; _i < 2; ++_i) \
        __builtin_amdgcn_global_load_lds((const unsigned*)((const char*)(gbase) + (voff)[_i]), (LAS unsigned*)(lds + (bufoff) + ldsw + _i * 8192), 16, 0, 0); } while (0)
#define PG8_STAGE_A(bufoff, gbase, h, offs) do { if constexpr (Sched::GATHER) { PG8_STAGE(bufoff, gbase, (offs)[h]); } else { PG8_STAGE(bufoff, (gbase) + (h) * hstepA, voffA); } } while (0)
#define PG8_LDA(dst, b, h) do { _Pragma("unroll") for (int m = 0; m < 4; ++m) _Pragma("unroll") for (int k = 0; k < 2; ++k) dst[m][k] = *(const LAS bf16x8*)(lds + PG8_SA(b, h) + aoff + m * 2048 + k * 1024); } while (0)
#define PG8_LDB(dst, b, h) do { _Pragma("unroll") for (int n = 0; n < 2; ++n) _Pragma("unroll") for (int k = 0; k < 2; ++k) dst[n][k] = *(const LAS bf16x8*)(lds + PG8_SB(b, h) + boff + n * 2048 + k * 1024); } while (0)
#define PG8_MMA(ai, bj, At, Bt) do { __builtin_amdgcn_s_setprio(1); _Pragma("unroll") for (int m = 0; m < 4; ++m) _Pragma("unroll") for (int n = 0; n < 2; ++n) _Pragma("unroll") for (int k = 0; k < 2; ++k) \
        acc[ai][bj][m][n] = __builtin_amdgcn_mfma_f32_16x16x32_bf16(Bt[n][k], At[m][k], acc[ai][bj][m][n], 0, 0, 0); __builtin_amdgcn_s_setprio(0); } while (0)
#define PG8_WAIT_V(n) asm volatile("s_waitcnt vmcnt(" #n ")" ::: "memory")
#define PG8_WAIT_L(n) asm volatile("s_waitcnt lgkmcnt(" #n ")" ::: "memory")
#define PG8_BAR __builtin_amdgcn_s_barrier()
#define PG8_SCHED __builtin_amdgcn_sched_barrier(0)
    Unit cur, nxt; int ui = 0;
    if (!S.next(0, cur)) return;
    f32x4 acc[2][2][4][2];
#pragma unroll
    for (int a = 0; a < 2; ++a)
#pragma unroll
        for (int b = 0; b < 2; ++b)
#pragma unroll
            for (int m = 0; m < 4; ++m)
#pragma unroll
                for (int n = 0; n < 2; ++n) acc[a][b][m][n] = (f32x4){0.f, 0.f, 0.f, 0.f};
    bf16x8 At[4][2], B0[2][2], B1[2][2];
    unsigned cOff[2][2], nOff[2][2];
    if constexpr (Sched::GATHER) {
#pragma unroll
        for (int h = 0; h < 2; ++h)
#pragma unroll
            for (int i = 0; i < 2; ++i) { cOff[h][i] = S.arow(cur, h * HALF + RA[i]) + (unsigned)CA[i] * 2u; nOff[h][i] = cOff[h][i]; }
        asm volatile("" : "+v"(cOff[0][0]), "+v"(cOff[0][1]), "+v"(cOff[1][0]), "+v"(cOff[1][1]));
    }
    const char* cA = S.abase(cur); const char* cB = S.bbase(cur);
    if constexpr (SP2) {
        PG8_STAGE(PG8_SB(0, 0), cB, voffB); PG8_STAGE(PG8_SB(0, 1), cB + hstepB, voffB); PG8_STAGE_A(PG8_SA(0, 0), cA, 0, cOff); PG8_STAGE_A(PG8_SA(0, 1), cA, 1, cOff);
        if (wr == 1) PG8_BAR;
        PG8_WAIT_V(2); PG8_BAR;
        PG8_STAGE(PG8_SB(1, 0), cB + kstep, voffB); PG8_STAGE_A(PG8_SA(1, 0), cA + kstep, 0, cOff); PG8_STAGE(PG8_SB(1, 1), cB + hstepB + kstep, voffB);
        PG8_WAIT_V(6); PG8_BAR;
    } else {
        PG8_STAGE(PG8_SB(0, 0), cB, voffB); PG8_STAGE_A(PG8_SA(0, 0), cA, 0, cOff); PG8_STAGE(PG8_SB(0, 1), cB + hstepB, voffB); PG8_STAGE_A(PG8_SA(0, 1), cA, 1, cOff);
        if (wr == 1) PG8_BAR;
        PG8_WAIT_V(4); PG8_BAR;
        PG8_STAGE(PG8_SB(1, 0), cB + kstep, voffB); PG8_STAGE_A(PG8_SA(1, 0), cA + kstep, 0, cOff); PG8_STAGE(PG8_SB(1, 1), cB + hstepB + kstep, voffB);
        PG8_WAIT_V(6); PG8_BAR;
    }
    for (;;) {
        const bool has_next = S.next(ui + 1, nxt);
        const char* nA = has_next ? S.abase(nxt) : cA; const char* nB = has_next ? S.bbase(nxt) : cB;
        if constexpr (Sched::GATHER) {
            if (has_next) {
#pragma unroll
                for (int h = 0; h < 2; ++h)
#pragma unroll
                    for (int i = 0; i < 2; ++i) nOff[h][i] = S.arow(nxt, h * HALF + RA[i]) + (unsigned)CA[i] * 2u;
                asm volatile("" : "+v"(nOff[0][0]), "+v"(nOff[0][1]), "+v"(nOff[1][0]), "+v"(nOff[1][1]));
            }
        }
        for (int t = 0; t < nt; t += 2) {
            const bool last = (t == nt - 2);
            const char* a1 = cA + (size_t)(t + 1) * kstep;
            const char* a2 = last ? nA : cA + (size_t)(t + 2) * kstep; const char* b2 = last ? nB : cB + (size_t)(t + 2) * kstep;
            const char* a3 = a2 + kstep; const char* b3 = b2 + kstep;
            unsigned o2[2][2];
            if constexpr (Sched::GATHER) {
#pragma unroll
                for (int h = 0; h < 2; ++h)
#pragma unroll
                    for (int i = 0; i < 2; ++i) o2[h][i] = last ? nOff[h][i] : cOff[h][i];
            }
            if constexpr (SP2) {
            PG8_LDB(B0, 0, 0); PG8_LDB(B1, 0, 1); PG8_SCHED; PG8_LDA(At, 0, 0); PG8_STAGE_A(PG8_SA(1, 1), a1, 1, cOff);
            PG8_WAIT_V(8); PG8_WAIT_L(0); PG8_BAR; PG8_MMA(0, 0, At, B0); PG8_MMA(0, 1, At, B1); PG8_BAR; PG8_SCHED;
            PG8_LDA(At, 0, 1); PG8_STAGE(PG8_SB(0, 0), b2, voffB); PG8_STAGE(PG8_SB(0, 1), b2 + hstepB, voffB); PG8_STAGE_A(PG8_SA(0, 0), a2, 0, o2);
            PG8_WAIT_V(8); PG8_WAIT_L(0); PG8_BAR; PG8_MMA(1, 0, At, B0); PG8_MMA(1, 1, At, B1); PG8_BAR; PG8_SCHED;
            PG8_LDB(B0, 1, 0); PG8_LDB(B1, 1, 1); PG8_SCHED; PG8_LDA(At, 1, 0); PG8_STAGE_A(PG8_SA(0, 1), a2, 1, o2);
            PG8_WAIT_V(8); PG8_WAIT_L(0); PG8_BAR; PG8_MMA(0, 0, At, B0); PG8_MMA(0, 1, At, B1); PG8_BAR; PG8_SCHED;
            PG8_LDA(At, 1, 1); PG8_STAGE(PG8_SB(1, 0), b3, voffB); PG8_STAGE(PG8_SB(1, 1), b3 + hstepB, voffB); PG8_STAGE_A(PG8_SA(1, 0), a3, 0, o2);
            PG8_WAIT_V(8); PG8_WAIT_L(0); PG8_BAR; PG8_MMA(1, 0, At, B0); PG8_MMA(1, 1, At, B1); PG8_BAR; PG8_SCHED;
            } else {
            PG8_LDB(B0, 0, 0); PG8_SCHED; PG8_LDA(At, 0, 0); PG8_STAGE_A(PG8_SA(1, 1), a1, 1, cOff);
            PG8_WAIT_L(8); PG8_BAR; PG8_WAIT_L(0); PG8_MMA(0, 0, At, B0); PG8_BAR; PG8_SCHED;
            PG8_LDB(B1, 0, 1); PG8_STAGE(PG8_SB(0, 0), b2, voffB);
            PG8_BAR; PG8_WAIT_L(0); PG8_MMA(0, 1, At, B1); PG8_BAR;
            PG8_LDA(At, 0, 1); PG8_STAGE_A(PG8_SA(0, 0), a2, 0, o2);
            PG8_BAR; PG8_WAIT_L(0); PG8_MMA(1, 0, At, B0); PG8_BAR; PG8_SCHED;
            PG8_STAGE(PG8_SB(0, 1), b2 + hstepB, voffB);
            PG8_WAIT_V(6); PG8_BAR; PG8_MMA(1, 1, At, B1); PG8_BAR;
            PG8_LDB(B0, 1, 0); PG8_SCHED; PG8_LDA(At, 1, 0); PG8_STAGE_A(PG8_SA(0, 1), a2, 1, o2);
            PG8_WAIT_L(8); PG8_BAR; PG8_WAIT_L(0); PG8_MMA(0, 0, At, B0); PG8_BAR; PG8_SCHED;
            PG8_LDB(B1, 1, 1); PG8_STAGE(PG8_SB(1, 0), b3, voffB);
            PG8_BAR; PG8_WAIT_L(0); PG8_MMA(0, 1, At, B1); PG8_BAR;
            PG8_LDA(At, 1, 1); PG8_STAGE_A(PG8_SA(1, 0), a3, 0, o2);
            PG8_BAR; PG8_WAIT_L(0); PG8_MMA(1, 0, At, B0); PG8_BAR; PG8_SCHED;
            PG8_STAGE(PG8_SB(1, 1), b3 + hstepB, voffB);
            PG8_WAIT_V(6); PG8_BAR; PG8_MMA(1, 1, At, B1); PG8_BAR;
            }
        }
        if constexpr (ALIGN_EPI) { if (wr == 0) PG8_BAR; }
        { int tz = threadIdx.x; asm volatile("" : "+v"(tz));
          const int lz = tz & 63; E(acc, cur, wr, wc, lz & 15, lz >> 4); }
        if (!has_next) break;
#pragma unroll
        for (int a = 0; a < 2; ++a)
#pragma unroll
            for (int b = 0; b < 2; ++b)
#pragma unroll
                for (int m = 0; m < 4; ++m)
#pragma unroll
                    for (int n = 0; n < 2; ++n) acc[a][b][m][n] = (f32x4){0.f, 0.f, 0.f, 0.f};
        cur = nxt; cA = nA; cB = nB; ++ui;
        if constexpr (Sched::GATHER) {
#pragma unroll
            for (int h = 0; h < 2; ++h)
#pragma unroll
                for (int i = 0; i < 2; ++i) cOff[h][i] = nOff[h][i];
        }
        if constexpr (ALIGN_EPI) { if (wr == 1) PG8_BAR; }
    }
    PG8_WAIT_V(0);
    if constexpr (!ALIGN_EPI) { if (wr == 0) PG8_BAR; }
    PG8_BAR;
#undef PG8_SA
#undef PG8_SB
#undef PG8_STAGE
#undef PG8_STAGE_A
#undef PG8_LDA
#undef PG8_LDB
#undef PG8_MMA
#undef PG8_WAIT_V
#undef PG8_WAIT_L
#undef PG8_BAR
#undef PG8_SCHED
}
}

#define XB_TMO      128
#define XB_XCNT(j)  (256  + 64 * (j))
#define XB_XSUB(j)  (1280 + 64 * (j))
#define XB_XGEN(j)  (2304 + 64 * (j))
#define XB_TOP      3328
#define XB_TOPGEN   3392
#define XCD_BAR_WORDS 3456
#define XB_SPIN_CAP (1u << 18)
__device__ __forceinline__ unsigned xb_ld(unsigned* p)              { return __hip_atomic_load(p, __ATOMIC_RELAXED, __HIP_MEMORY_SCOPE_AGENT); }
__device__ __forceinline__ unsigned xb_add(unsigned* p, unsigned v) { return __hip_atomic_fetch_add(p, v, __ATOMIC_RELAXED, __HIP_MEMORY_SCOPE_AGENT); }
__device__ __forceinline__ unsigned xb_xcc_id() { return (unsigned)__builtin_amdgcn_s_getreg((3 << 11) | 20) & 0xFu; }
#define XB_SPIN(cond, bar) do { unsigned _sp = 0; while (cond) { __builtin_amdgcn_s_sleep(1); \
    if ((++_sp & 255u) == 0u) { if (xb_ld(&(bar)[XB_TMO])) break; if (_sp > XB_SPIN_CAP) { atomicAdd(&(bar)[XB_TMO], 1u); break; } } } } while (0)
struct XcdBarrier { unsigned* bar; unsigned x; volatile LAS unsigned* st; };
__device__ __forceinline__ XcdBarrier xcd_barrier_post(unsigned* bar, volatile LAS unsigned* st) {
    XcdBarrier b; b.bar = bar; b.x = xb_xcc_id(); b.st = st;
    if (threadIdx.x == 0) (void)xb_add(&bar[XB_XCNT(b.x)], 1u);
    return b;
}
__device__ __forceinline__ void xcd_barrier_complete(unsigned* bar, unsigned x, unsigned& nloc, unsigned& nx) {
    const unsigned G = gridDim.x * gridDim.y * gridDim.z;
    unsigned sum, cnt, mine, sp = 0u;
    for (;;) {
        sum = 0u; cnt = 0u; mine = 0u;
#pragma unroll
        for (unsigned j = 0; j < 16; ++j) { const unsigned c = xb_ld(&bar[XB_XCNT(j)]); sum += c; cnt += (c > 0u) ? 1u : 0u; mine = (j == x) ? c : mine; }
        if (sum == G) break;
        __builtin_amdgcn_s_sleep(1);
        if ((++sp & 255u) == 0u) { if (xb_ld(&bar[XB_TMO])) break; if (sp > XB_SPIN_CAP) { atomicAdd(&bar[XB_TMO], 1u); break; } }
    }
    nloc = mine > 0u ? mine : 1u; nx = cnt > 0u ? cnt : 1u;
}
__device__ __forceinline__ void xcd_barrier(const XcdBarrier& b) {
    asm volatile("s_waitcnt vmcnt(0)" ::: "memory");
    __syncthreads();
    if (threadIdx.x == 0) {
        unsigned* bar = b.bar;
        __builtin_amdgcn_s_waitcnt(0);
        unsigned nloc = b.st[0], nx = b.st[1];
        if (nloc == 0u) { xcd_barrier_complete(bar, b.x, nloc, nx); b.st[0] = nloc; b.st[1] = nx; }
        const unsigned old = xb_add(&bar[XB_XSUB(b.x)], 1u);
        const unsigned gen = old / nloc;
        if (old + 1u == (gen + 1u) * nloc) {
            __builtin_amdgcn_fence(__ATOMIC_RELEASE, "agent");
            asm volatile("s_waitcnt vmcnt(0)" ::: "memory");
            const unsigned og = xb_add(&bar[XB_TOP], 1u);
            const unsigned tg = og / nx;
            if (og + 1u == (tg + 1u) * nx) xb_add(&bar[XB_TOPGEN], 1u);
            else XB_SPIN(xb_ld(&bar[XB_TOPGEN]) == tg, bar);
            __builtin_amdgcn_fence(__ATOMIC_ACQUIRE, "agent");
            xb_add(&bar[XB_XGEN(b.x)], 1u);
            asm volatile("s_waitcnt vmcnt(0)" ::: "memory");
        } else {
            XB_SPIN(xb_ld(&bar[XB_XGEN(b.x)]) == gen, bar);
            __builtin_amdgcn_fence(__ATOMIC_ACQUIRE, "agent");
            asm volatile("s_waitcnt vmcnt(0)" ::: "memory");
        }
    }
    __syncthreads();
}

using pg8::Unit;
typedef const f32x4 (&AccRef)[2][2][4][2];
DI u32x4 pack8(const f32x4& a, const f32x4& b) { u32x4 w; w.x = cvt_pk_bf16(a[0], a[1]); w.y = cvt_pk_bf16(a[2], a[3]); w.z = cvt_pk_bf16(b[0], b[1]); w.w = cvt_pk_bf16(b[2], b[3]); return w; }

struct EpiStoreBf16 {
    static constexpr bool PERM = true;
    bf16* O; int ldc;
    DI void operator()(AccRef acc, const Unit& u, int wr, int wc, int fr, int fq) const {
        const int row0 = u.pm * 256 + wr * 64 + fr, col0 = u.pn * 256 + wc * 32 + 8 * fq;
#pragma unroll
        for (int ai = 0; ai < 2; ++ai)
#pragma unroll
            for (int m = 0; m < 4; ++m) { bf16* rowp = O + (size_t)(row0 + ai * 128 + m * 16) * ldc + col0;
#pragma unroll
                for (int bj = 0; bj < 2; ++bj) *(u32x4*)(rowp + bj * 128) = pack8(acc[ai][bj][m][0], acc[ai][bj][m][1]); }
    }
};
struct EpiUp {
    static constexpr bool PERM = true;
    bf16* Q; bf16* KN; bf16* VT; const float* ropec; const float* ropes;
    DI void operator()(AccRef acc, const Unit& u, int wr, int wc, int fr, int fq) const {
        const int rl0 = wr * 64 + fr, b = u.pm / 9, s00 = (u.pm % 9) * 256;
        if (u.pn < 3) {
#pragma unroll
            for (int ai = 0; ai < 2; ++ai)
#pragma unroll
                for (int m = 0; m < 4; ++m) { const int rl = rl0 + ai * 128 + m * 16, s = s00 + rl; const size_t row = (size_t)u.pm * 256 + rl;
#pragma unroll
                    for (int bj = 0; bj < 2; ++bj) { const int c0 = u.pn * 256 + bj * 128 + wc * 32 + 8 * fq, w = c0 % 96;
                        f32x4 v0 = acc[ai][bj][m][0] * QSCALE, v1 = acc[ai][bj][m][1] * QSCALE;
                        if (w >= 64 && s >= CTXL) { const int i0 = (w - 64) >> 1; const f32x4 cs = *(const f32x4*)(ropec + (size_t)(s - CTXL) * 16 + i0), sn = *(const f32x4*)(ropes + (size_t)(s - CTXL) * 16 + i0);
                            f32x4 r0, r1;
                            r0[0] = v0[0] * cs[0] - v0[1] * sn[0]; r0[1] = v0[1] * cs[0] + v0[0] * sn[0];
                            r0[2] = v0[2] * cs[1] - v0[3] * sn[1]; r0[3] = v0[3] * cs[1] + v0[2] * sn[1];
                            r1[0] = v1[0] * cs[2] - v1[1] * sn[2]; r1[1] = v1[1] * cs[2] + v1[0] * sn[2];
                            r1[2] = v1[2] * cs[3] - v1[3] * sn[3]; r1[3] = v1[3] * cs[3] + v1[2] * sn[3];
                            v0 = r0; v1 = r1; }
                        *(u32x4*)(Q + row * 768 + c0) = pack8(v0, v1); }
                    asm volatile("" ::: "memory"); }
        } else {
#pragma unroll
            for (int ai = 0; ai < 2; ++ai)
#pragma unroll
                for (int m = 0; m < 4; ++m) { const int rl = rl0 + ai * 128 + m * 16, s = s00 + rl; const size_t row = (size_t)u.pm * 256 + rl;
#pragma unroll
                    for (int bj = 0; bj < 2; ++bj) { const int head = (u.pn - 3) * 2 + bj, within = wc * 32 + 8 * fq;
                        if (wc < 2) *(u32x4*)(KN + row * 512 + head * 64 + within) = pack8(acc[ai][bj][m][0], acc[ai][bj][m][1]);
                        else { bf16* vp = VT + ((size_t)(b * 8 + head) * 64 + (within - 64)) * LT + s;
#pragma unroll
                            for (int n = 0; n < 2; ++n)
#pragma unroll
                                for (int j = 0; j < 4; ++j) vp[(size_t)(4 * n + j) * LT] = (bf16)f2bf(acc[ai][bj][m][n][j]); } }
                    asm volatile("" ::: "memory"); }
        }
    }
};
struct EpiResid {
    static constexpr bool PERM = true;
    bf16* XS; const float* gate;
    DI void operator()(AccRef acc, const Unit& u, int wr, int wc, int fr, int fq) const {
        const int mr = (u.pm % 9 == 0) ? 8 : u.pm / 9;
        const int row0 = u.pm * 256 + wr * 64 + fr, col0 = u.pn * 256 + wc * 32 + 8 * fq;
        f32x4 g[2][2];
#pragma unroll
        for (int bj = 0; bj < 2; ++bj)
#pragma unroll
            for (int n = 0; n < 2; ++n) g[bj][n] = *(const f32x4*)(gate + (size_t)mr * 6144 + col0 + bj * 128 + n * 4);
#pragma unroll
        for (int ai = 0; ai < 2; ++ai) {
            u32x4 ov[4][2];
#pragma unroll
            for (int m = 0; m < 4; ++m)
#pragma unroll
                for (int bj = 0; bj < 2; ++bj) ov[m][bj] = *(const u32x4*)(XS + (size_t)(row0 + ai * 128 + m * 16) * D + col0 + bj * 128);
#pragma unroll
            for (int m = 0; m < 4; ++m) { bf16* rowp = XS + (size_t)(row0 + ai * 128 + m * 16) * D + col0;
#pragma unroll
                for (int bj = 0; bj < 2; ++bj) { const u32x4 o = ov[m][bj]; f32x4 x0, x1;
                    x0[0] = bf2f(o.x & 0xffffu); x0[1] = bf2f(o.x >> 16); x0[2] = bf2f(o.y & 0xffffu); x0[3] = bf2f(o.y >> 16); x1[0] = bf2f(o.z & 0xffffu); x1[1] = bf2f(o.z >> 16); x1[2] = bf2f(o.w & 0xffffu); x1[3] = bf2f(o.w >> 16);
                    *(u32x4*)(rowp + bj * 128) = pack8(x0 + g[bj][0] * acc[ai][bj][m][0], x1 + g[bj][1] * acc[ai][bj][m][1]); } }
            asm volatile("" ::: "memory"); }
    }
};
struct EpiSwiglu {
    static constexpr bool PERM = true;
    bf16* O; int ldc;
    DI void operator()(AccRef acc, const Unit& u, int wr, int wc, int fr, int fq) const {
        const int row0 = u.pm * 256 + wr * 64 + fr, col0 = u.pn * 128 + wc * 32 + 8 * fq;
#pragma unroll
        for (int ai = 0; ai < 2; ++ai)
#pragma unroll
            for (int m = 0; m < 4; ++m) { f32x4 y[2];
#pragma unroll
                for (int n = 0; n < 2; ++n)
#pragma unroll
                    for (int j = 0; j < 4; ++j) { const float g = acc[ai][0][m][n][j]; y[n][j] = g * __builtin_amdgcn_rcpf(1.f + __expf(-g)) * acc[ai][1][m][n][j]; }
                *(u32x4*)(O + (size_t)(row0 + ai * 128 + m * 16) * ldc + col0) = pack8(y[0], y[1]); }
    }
};
struct EpiOddIn {
    static constexpr bool PERM = true;
    bf16* QKVR; bf16* GATE; float* AB;
    DI void operator()(AccRef acc, const Unit& u, int wr, int wc, int fr, int fq) const {
        const int row0 = u.pm * 256 + wr * 64 + fr, cw = wc * 32 + 8 * fq;
#pragma unroll
        for (int ai = 0; ai < 2; ++ai)
#pragma unroll
            for (int m = 0; m < 4; ++m) { const size_t row = (size_t)(row0 + ai * 128 + m * 16);
                if (u.pn < 12) {
#pragma unroll
                    for (int bj = 0; bj < 2; ++bj) *(u32x4*)(QKVR + row * 3072 + u.pn * 256 + bj * 128 + cw) = pack8(acc[ai][bj][m][0], acc[ai][bj][m][1]);
                } else if (u.pn < 16) {
#pragma unroll
                    for (int bj = 0; bj < 2; ++bj) *(u32x4*)(GATE + row * 1024 + (u.pn - 12) * 256 + bj * 128 + cw) = pack8(acc[ai][bj][m][0], acc[ai][bj][m][1]);
                } else if (wc == 0) {
                    *(f32x4*)(AB + row * 32 + 8 * fq) = acc[ai][0][m][0]; *(f32x4*)(AB + row * 32 + 8 * fq + 4) = acc[ai][0][m][1];
                } }
    }
};
struct EpiMoeDown {
    static constexpr bool PERM = true;
    bf16* YM; const float* GWt;
    DI void operator()(AccRef acc, const Unit& u, int wr, int wc, int fr, int fq) const {
        const int rl0 = wr * 64 + fr, col0 = u.pn * 256 + wc * 32 + 8 * fq;
        const int ex = u.e & 255, r0 = u.e >> 8, cnt = u.cnt;
        float gwa[2][4];
#pragma unroll
        for (int ai = 0; ai < 2; ++ai)
#pragma unroll
            for (int m = 0; m < 4; ++m) gwa[ai][m] = GWt[(size_t)ex * T + r0 + rl0 + ai * 128 + m * 16];
        asm volatile("" : "+v"(gwa[0][0]), "+v"(gwa[0][1]), "+v"(gwa[0][2]), "+v"(gwa[0][3]), "+v"(gwa[1][0]), "+v"(gwa[1][1]), "+v"(gwa[1][2]), "+v"(gwa[1][3]));
#pragma unroll
        for (int ai = 0; ai < 2; ++ai)
#pragma unroll
            for (int m = 0; m < 4; ++m) { const int rl = rl0 + ai * 128 + m * 16, p = r0 + rl;
                if (p < cnt) { const float gwv = gwa[ai][m]; bf16* rowp = YM + ((size_t)u.pm * 256 + rl) * D + col0;
#pragma unroll
                    for (int bj = 0; bj < 2; ++bj) *(u32x4*)(rowp + bj * 128) = pack8(acc[ai][bj][m][0] * gwv, acc[ai][bj][m][1] * gwv); } }
    }
};

template <bool GATHER_> struct MoeOrder {
    static constexpr bool GATHER = GATHER_;
    const bf16* A; const bf16* Bt; int lda, ldb; size_t bexp;
    const int* list; const LAS int* tab;
    int NN, G, c, hi;
    DI bool locate(long L, Unit& u) const {
        int tb = 0; bool found = false;
        const u32x4 c03 = *(const LAS u32x4*)tab, c47 = *(const LAS u32x4*)(tab + 4); const int cea[NEXP] = {(int)c03.x, (int)c03.y, (int)c03.z, (int)c03.w, (int)c47.x, (int)c47.y, (int)c47.z, (int)c47.w};
#pragma unroll
        for (int e = 0; e < NEXP; ++e) { const int ce = cea[e], te = (ce + 255) >> 8; const long ue = (long)te * NN;
            if (!found) { if (L < ue) { found = true; const int mt = GATHER ? (int)((L / 4) % te) : (int)(L / NN), pn = GATHER ? (int)((L / (4 * te)) * 4 + (L % 4)) : (int)(L % NN); u.pm = tb + mt;   u.pn = pn; u.e = ((mt * 256) << 8) | e; u.cnt = ce; u.aux = 0; } else { L -= ue; tb += te; } } }
        return found;
    }
    DI bool next(int i, Unit& u) const { const long L = (long)i * G + c; if (L >= hi) return false; return locate(L, u); }
    DI const char* abase(const Unit& u) const { return GATHER ? (const char*)A : (const char*)A + (size_t)u.pm * 256 * lda * 2; }
    DI const char* bbase(const Unit& u) const { return (const char*)Bt + ((size_t)(u.e & 255) * bexp + (size_t)u.pn * 256 * ldb) * 2; }
    DI unsigned arow(const Unit& u, int r) const { const int p = (u.e >> 8) + r; return (unsigned)list[(size_t)(u.e & 255) * T + p] * (unsigned)(lda * 2); }
};
struct MoeTailOrder {
    static constexpr bool GATHER = false;
    MoeOrder<false> M; int full, R, S, KS;
    DI bool next(int i, Unit& u) const { if (i > 0 || M.c >= R * S) return false; const int ut = M.c / S, ks = M.c % S; const bool ok = M.locate((long)full + ut, u); u.aux = (ut << 8) | ks; return ok; }
    DI const char* abase(const Unit& u) const { return M.abase(u) + (size_t)(u.aux & 255) * KS * 2; }
    DI const char* bbase(const Unit& u) const { return M.bbase(u) + (size_t)(u.aux & 255) * KS * 2; }
    DI unsigned arow(const Unit&, int) const { return 0u; }
};
struct EpiMoeDownPart {
    static constexpr bool PERM = true;
    bf16* PB; const float* GWt;
    DI void operator()(AccRef acc, const Unit& u, int wr, int wc, int fr, int fq) const {
        const int rl0 = wr * 64 + fr, cw = wc * 32 + 8 * fq, ex = u.e & 255, r0 = u.e >> 8, cnt = u.cnt;
        bf16* base = PB + ((size_t)(u.aux & 255) * 128 + (u.aux >> 8)) * 65536;
        float gwa[2][4];
#pragma unroll
        for (int ai = 0; ai < 2; ++ai)
#pragma unroll
            for (int m = 0; m < 4; ++m) gwa[ai][m] = GWt[(size_t)ex * T + r0 + rl0 + ai * 128 + m * 16];
        (void)cnt;
#pragma unroll
        for (int ai = 0; ai < 2; ++ai)
#pragma unroll
            for (int m = 0; m < 4; ++m) { const int rl = rl0 + ai * 128 + m * 16, p = r0 + rl; const float gwv = gwa[ai][m];
#pragma unroll
                for (int bj = 0; bj < 2; ++bj) *(u32x4*)(base + (size_t)rl * 256 + bj * 128 + cw) = pack8(acc[ai][bj][m][0] * gwv, acc[ai][bj][m][1] * gwv); }
    }
};

DI void transpose_item(const float* W, int ldw, bf16* WT, int ldt, int k0, int kd0, int n0, int sc, LAS float* scr, int lane) {
    const int scc = sc < 0 ? 0 : sc; const float msk = sc < 0 ? 0.f : 1.f;
    const float* wp = W + (size_t)(k0 + (lane >> 5)) * ldw + scc;
#pragma unroll 8
    for (int i = 0; i < 32; ++i) scr[(2 * i + (lane >> 5)) * 33 + (lane & 31)] = __builtin_nontemporal_load(wp + (size_t)(2 * i) * ldw) * msk;
    LDS_WAIT(); asm volatile("" ::: "memory");
    const int c = lane & 7;
#pragma unroll
    for (int j = 0; j < 4; ++j) { const int n = (lane >> 3) + 8 * j; const LAS float* s = scr + (8 * c) * 33 + n;
        u32x4 o; o.x = cvt_pk_bf16(s[0 * 33], s[1 * 33]); o.y = cvt_pk_bf16(s[2 * 33], s[3 * 33]); o.z = cvt_pk_bf16(s[4 * 33], s[5 * 33]); o.w = cvt_pk_bf16(s[6 * 33], s[7 * 33]);
        *(u32x4*)(WT + (size_t)(n0 + n) * ldt + kd0 + k0 + 8 * c) = o; }
    LDS_WAIT(); asm volatile("" ::: "memory");
}
DI void conv_job(int& it, int NGW, const float* W, int ldw, int Ksrc, bf16* WT, int ldt, int kd0, int ndst, int mode, int p0, int nsrc, LAS float* scr, int lane) {
    const int nnb = ndst / 32, items = (Ksrc / 64) * nnb;
    for (; it < items; it += NGW) {
        const int kb = it / nnb, nb = it % nnb, n = nb * 32 + (lane & 31);
        int sc;
        if (mode == 0) sc = n < nsrc ? n : -1;
        else if (mode == 1) { const int g = (n >> 7) & 1, p = n >> 8, j = n & 127; sc = g * p0 + 128 * p + j; }
        else { const int h = n / 96, w = n % 96; if (w < 64) sc = n; else { const int idx = w - 64, i = idx >> 1, ab = idx & 1; const int o = ab ? (i < 8 ? 8 + i : 16 + i) : (i < 8 ? i : 8 + i); sc = h * 96 + 64 + o; } }
        transpose_item(W, ldw, WT, ldt, kb * 64, kd0, nb * 32, sc, scr, lane);
    }
    it -= items;
}
struct Args { const float* in[57]; float* out; unsigned char* ws; int ph_lo, ph_hi; };

DI void convert_layer(const Args& a, unsigned char* ws, int layer, LAS unsigned char* lds, int G, int bx) {
    int tid = threadIdx.x; asm volatile("" : "+v"(tid));
    const int lane = tid & 63, wave = __builtin_amdgcn_readfirstlane(tid >> 6), gw = bx * NWAVES + wave, NGW = G * NWAVES, gtid = bx * NTHR + tid, NGT = G * NTHR;
    (void)lane; (void)wave; (void)gw; (void)NGW; (void)gtid; (void)NGT;
    LAS float* scr = (LAS float*)(lds + wave * 8448);
    int it = gw; unsigned char* wb = ws + WS_W;
    if ((layer & 1) == 0) {
        conv_job(it, NGW, a.in[LIN(layer, 3)], EVEN_IN, D, (bf16*)(wb + WE_IN), D, 0, EVEN_INP, 0, 0, EVEN_IN, scr, lane);
        conv_job(it, NGW, a.in[LIN(layer, 6)], 768, 256, (bf16*)(wb + WE_UP), UP_K, 0, 768, 2, 0, 768, scr, lane);
        conv_job(it, NGW, a.in[LIN(layer, 8)], 1024, 128, (bf16*)(wb + WE_UP) + (size_t)768 * UP_K, UP_K, 256, 1024, 0, 0, 1024, scr, lane);
        conv_job(it, NGW, a.in[LIN(layer, 9)], D, D, (bf16*)(wb + WE_OUT), D, 0, D, 0, 0, D, scr, lane);
        conv_job(it, NGW, a.in[LIN(layer, 11)], 2 * FFN_F, D, (bf16*)(wb + WE_W1), D, 0, 2 * FFN_F, 1, FFN_F, 0, scr, lane);
        conv_job(it, NGW, a.in[LIN(layer, 12)], D, FFN_F, (bf16*)(wb + WE_W2), FFN_F, 0, D, 0, 0, D, scr, lane);
        bf16* up = (bf16*)(wb + WE_UP); const u32x4 z = (u32x4){0u, 0u, 0u, 0u};
        for (int i = gtid; i < 768 * 16; i += NGT) *(u32x4*)(up + (size_t)(i >> 4) * UP_K + 256 + (i & 15) * 8) = z;
        for (int i = gtid; i < 1024 * 32; i += NGT) *(u32x4*)(up + (size_t)(768 + (i >> 5)) * UP_K + (i & 31) * 8) = z;
    } else {
        unsigned char* wo = ws + WS_WO;
        conv_job(it, NGW, a.in[LIN(layer, 3)], ODD_IN, D, (bf16*)(wo + WO_IN), D, 0, ODD_INP, 0, 0, ODD_IN, scr, lane);
        conv_job(it, NGW, a.in[LIN(layer, 8)], D, D, (bf16*)(wo + WO_OUT), D, 0, D, 0, 0, D, scr, lane);
    }
}
constexpr int MOE_ITEMS_E = 3584 + 1792, MOE_ITEMS = NEXP * MOE_ITEMS_E, MOE_Q1 = 10752, MOE_Q2 = 39424;
DI void convert_moe(const Args& a, unsigned char* ws, int layer, LAS unsigned char* lds, int w, int nw, int lo, int hi) {
    int tid = threadIdx.x; asm volatile("" : "+v"(tid));
    const int lane = tid & 63, wave = __builtin_amdgcn_readfirstlane(tid >> 6);
    LAS float* scr = (LAS float*)(lds + wave * 8448); unsigned char* wo = ws + WS_WO;
    for (int idx = lo + w; idx < hi; idx += nw) {
        const int e = idx / MOE_ITEMS_E, r = idx % MOE_ITEMS_E;
        if (r < 3584) { const int kb = r / 224, nb = r % 224, n = nb * 32 + (lane & 31); const int g = (n >> 7) & 1, p = n >> 8, j = n & 127;
            transpose_item(a.in[LIN(layer, 11)] + (size_t)e * D * 2 * MOE_F, 2 * MOE_F, (bf16*)(wo + WO_W1) + (size_t)e * 2 * MOE_F * D, D, kb * 64, 0, nb * 32, g * MOE_F + 128 * p + j, scr, lane); }
        else { const int r2 = r - 3584, kb = r2 / 32, nb = r2 % 32;
            transpose_item(a.in[LIN(layer, 12)] + (size_t)e * MOE_F * D, D, (bf16*)(wo + WO_W2) + (size_t)e * D * MOE_F, MOE_F, kb * 64, 0, nb * 32, nb * 32 + (lane & 31), scr, lane); }
    }
}

DI void prologue_mod_partial(const Args& a, unsigned char* ws, LAS unsigned char* lds, int G, int bx) {
    int tid = threadIdx.x; asm volatile("" : "+v"(tid));
    const int lane = tid & 63, wave = __builtin_amdgcn_readfirstlane(tid >> 6), gw = bx * NWAVES + wave, NGW = G * NWAVES, gtid = bx * NTHR + tid, NGT = G * NTHR;
    float* ropec = (float*)(ws + WS_ROPE); float* ropes = ropec + 2048 * 16;
    for (int i = gtid; i < 2048 * 16; i += NGT) { const int pos = i >> 4, j = i & 15; const int rc = j < 8 ? (pos >> 6) : (pos & 63);
        const float inv = exp2f(-(float)(j & 7) * (13.287712379549449f / 8.f)); const float ang = (float)rc * inv; ropec[i] = cosf(ang); ropes[i] = sinf(ang); }
    LAS float* sc = (LAS float*)lds;
    for (int i = tid; i < 9 * 1024; i += NTHR) { const int r = i >> 10, k = i & 1023; const float v = r < 8 ? a.in[IN_C][r * 1024 + k] : a.in[IN_CCTX][k]; sc[k * 12 + r] = silu_f(v); }
    __syncthreads();
    float* part = (float*)(ws + WS_R0);
    for (int it = gw; it < 4 * 24 * 16; it += NGW) { const int layer = it / 384, cg = (it % 384) >> 4, ks = it & 15, n = cg * 256 + 4 * lane;
        const float* mw = a.in[LIN(layer, 0)] + (size_t)(ks * 64) * 6144 + n;
        f32x4 acc[9];
#pragma unroll
        for (int r = 0; r < 9; ++r) acc[r] = (f32x4){0.f, 0.f, 0.f, 0.f};
#pragma unroll 1
        for (int k8 = 0; k8 < 64; k8 += 8) {
        f32x4 wv[8];
#pragma unroll
        for (int k = 0; k < 8; ++k) wv[k] = *(const f32x4*)(mw + (size_t)(k8 + k) * 6144);
#pragma unroll
        for (int kk = 0; kk < 8; ++kk) { const int k = k8 + kk; const f32x4 w = wv[kk]; const LAS float* sp = sc + (ks * 64 + k) * 12; const f32x4 s0 = *(const LAS f32x4*)sp, s1 = *(const LAS f32x4*)(sp + 4); const float s8 = sp[8];
            acc[0] += w * s0[0]; acc[1] += w * s0[1]; acc[2] += w * s0[2]; acc[3] += w * s0[3]; acc[4] += w * s1[0]; acc[5] += w * s1[1]; acc[6] += w * s1[2]; acc[7] += w * s1[3]; acc[8] += w * s8; }
        }
#pragma unroll
        for (int r = 0; r < 9; ++r) *(f32x4*)(part + ((size_t)(ks * 4 + layer) * 9 + r) * 6144 + n) = acc[r]; }
    __syncthreads();
}
DI void prologue_mod_reduce(const Args& a, unsigned char* ws, int G, int bx) {
    int tid = threadIdx.x; asm volatile("" : "+v"(tid));
    const int gtid = bx * NTHR + tid, NGT = G * NTHR; const float* part = (const float*)(ws + WS_R0); float* mod = (float*)(ws + WS_MOD);
    for (int i = gtid; i < 4 * 9 * 1536; i += NGT) { const int layer = i / (9 * 1536), n = (i % 1536) * 4; f32x4 v = *(const f32x4*)(a.in[LIN(layer, 1)] + n);
#pragma unroll
        for (int ks = 0; ks < 16; ++ks) v = v + *(const f32x4*)(part + (size_t)ks * 4 * 9 * 6144 + (size_t)(i / 1536) * 6144 + n);
        *(f32x4*)(mod + (size_t)(i / 1536) * 6144 + n) = v; }
}

DI void norm_phase(const Args& a, unsigned char* ws, int layer, int which, int G, int bx) {
    int tid = threadIdx.x; asm volatile("" : "+v"(tid));
    const int lane = tid & 63, wave = __builtin_amdgcn_readfirstlane(tid >> 6), gw = bx * NWAVES + wave, NGW = G * NWAVES, gtid = bx * NTHR + tid, NGT = G * NTHR;
    (void)lane; (void)wave; (void)gw; (void)NGW; (void)gtid; (void)NGT;
    bf16* XS = (bf16*)(ws + WS_XS); bf16* H = (bf16*)(ws + WS_H);
    const bool from_in = (layer == 0 && which == 0), combine = (which == 2) || (which == 0 && layer > 0 && ((layer - 1) & 1));
    const int lprev = which == 2 ? 3 : layer - 1;
    const float* gvec = which == 2 ? a.in[IN_FINAL] : a.in[LIN(layer, which == 0 ? 2 : ((layer & 1) ? 9 : 10))];
    const float* mod = (float*)(ws + WS_MOD) + (size_t)(which == 2 ? 0 : layer) * 9 * 6144;
    const float* modp = (float*)(ws + WS_MOD) + (size_t)(lprev < 0 ? 0 : lprev) * 9 * 6144;
    const bool route = (which == 1) && (layer & 1);
    int tb[NEXP]; int tailL = 0x7fffffff, tailS = 1;
    if (combine) { const unsigned* cw = (const unsigned*)(ws + WS_CTL) + CW_CNT + (lprev >> 1) * 8 * 64; int acc = 0;
#pragma unroll
        for (int e = 0; e < NEXP; ++e) { tb[e] = acc; acc += ((int)__hip_atomic_load(cw + e * 64, __ATOMIC_RELAXED, __HIP_MEMORY_SCOPE_AGENT) + 255) >> 8; }
        const int U = acc * 4, full = (U / G) * G, R = U - full; tailS = (R == 0) ? 1 : (4 * R <= G ? 4 : (2 * R <= G ? 2 : 1)); if (tailS > 1) tailL = full; }
    const bf16* const PBp = (const bf16*)(ws + WS_END);
    f32x4 gv[4];
#pragma unroll
    for (int j = 0; j < 4; ++j) gv[j] = *(const f32x4*)(gvec + 4 * lane + 256 * j);
    f32x4 rw[16][2];
    if (route) { const float* rwp = a.in[LIN(layer, 10)];
#pragma unroll
        for (int j = 0; j < 4; ++j)
#pragma unroll
            for (int i = 0; i < 4; ++i) { const int k = 4 * lane + 256 * j + i; rw[4 * j + i][0] = *(const f32x4*)(rwp + (size_t)k * 8); rw[4 * j + i][1] = *(const f32x4*)(rwp + (size_t)k * 8 + 4); } }
    int kq = 0, pe0 = 0, pe1 = 0, pt = 0; float pw0 = 0.f;
    const int CHK_ = route ? (T + NGW - 1) / NGW : 0;
    u32x2 nrow[4];
#pragma unroll
    for (int j = 0; j < 4; ++j) nrow[j] = (u32x2){0u, 0u};
    { const int t0_ = route ? gw * CHK_ : gw; if (!from_in && t0_ < T) {
#pragma unroll
        for (int j = 0; j < 4; ++j) nrow[j] = *(const u32x2*)(XS + (size_t)t0_ * D + 4 * lane + 256 * j); } }
    for (int it_ = 0;; ++it_) {
        const int t = route ? gw * CHK_ + it_ : gw + it_ * NGW;
        if (t >= T || (route && it_ >= CHK_)) break;
        const int b = t / LT, s = t % LT, mr = s < CTXL ? 8 : b;
        const int tn_ = route ? t + 1 : t + NGW; const bool pfn_ = !from_in && tn_ < T;
        u32x2 pr_[4];
#pragma unroll
        for (int j = 0; j < 4; ++j) pr_[j] = nrow[j];
        if ((which == 2 || (which == 1 && layer == 3)) && s < CTXL) {
            if (pfn_) {
#pragma unroll
                for (int j = 0; j < 4; ++j) nrow[j] = *(const u32x2*)(XS + (size_t)tn_ * D + 4 * lane + 256 * j); }
            continue; }
        f32x4 shq[4], scq[4], g2q[4];
        if (which != 2) { const float* sh_ = mod + (size_t)mr * 6144 + (which == 0 ? 0 : 3 * 1024);
#pragma unroll
            for (int j = 0; j < 4; ++j) { shq[j] = *(const f32x4*)(sh_ + 4 * lane + 256 * j); scq[j] = *(const f32x4*)(sh_ + 1024 + 4 * lane + 256 * j); } }
        if (combine) {
#pragma unroll
            for (int j = 0; j < 4; ++j) g2q[j] = *(const f32x4*)(modp + (size_t)mr * 6144 + 5 * 1024 + 4 * lane + 256 * j); }
        f32x4 v[4];
        if (from_in) { const float* src = s < CTXL ? a.in[IN_CTX] + ((size_t)b * CTXL + s) * D : a.in[IN_X] + ((size_t)b * SEQ + (s - CTXL)) * D;
#pragma unroll
            for (int j = 0; j < 4; ++j) v[j] = *(const f32x4*)(src + 4 * lane + 256 * j);
        } else {
            if (pfn_) {
#pragma unroll
                for (int j = 0; j < 4; ++j) nrow[j] = *(const u32x2*)(XS + (size_t)tn_ * D + 4 * lane + 256 * j); }
            asm volatile("" ::: "memory");
#pragma unroll
            for (int j = 0; j < 4; ++j) { const u32x2 p = pr_[j]; v[j][0] = bf2f(p.x & 0xffffu); v[j][1] = bf2f(p.x >> 16); v[j][2] = bf2f(p.y & 0xffffu); v[j][3] = bf2f(p.y >> 16); }
        }
        if (combine) {
            const int4 tk = *(const int4*)(ws + WS_TOK + (size_t)t * 16);
            int t0 = 0, t1 = 0;
#pragma unroll
            for (int e = 0; e < NEXP; ++e) { t0 = tk.x == e ? tb[e] : t0; t1 = tk.z == e ? tb[e] : t1; }
            const int row0 = __builtin_amdgcn_readfirstlane(t0 * 256 + tk.y), row1 = __builtin_amdgcn_readfirstlane(t1 * 256 + tk.w);
            const bf16* ym = (const bf16*)(ws + WS_R1);
            u32x2 q0[4], q1[4];
#pragma unroll
            for (int j = 0; j < 4; ++j) { const int L0 = (row0 >> 8) * 4 + j, L1 = (row1 >> 8) * 4 + j;
                const bf16* a0 = L0 >= tailL ? PBp + ((size_t)(L0 - tailL) * 256 + (row0 & 255)) * 256 : ym + (size_t)row0 * D + 256 * j;
                const bf16* a1 = L1 >= tailL ? PBp + ((size_t)(L1 - tailL) * 256 + (row1 & 255)) * 256 : ym + (size_t)row1 * D + 256 * j;
                q0[j] = *(const u32x2*)(a0 + 4 * lane); q1[j] = *(const u32x2*)(a1 + 4 * lane); }
            f32x4 y[4];
#pragma unroll
            for (int j = 0; j < 4; ++j) { y[j][0] = bf2f(q0[j].x & 0xffffu) + bf2f(q1[j].x & 0xffffu); y[j][1] = bf2f(q0[j].x >> 16) + bf2f(q1[j].x >> 16); y[j][2] = bf2f(q0[j].y & 0xffffu) + bf2f(q1[j].y & 0xffffu); y[j][3] = bf2f(q0[j].y >> 16) + bf2f(q1[j].y >> 16); }
            if ((row0 >> 8) * 4 + 3 >= tailL || (row1 >> 8) * 4 + 3 >= tailL) {
#pragma unroll
                for (int j = 0; j < 4; ++j)
#pragma unroll
                    for (int sl = 0; sl < 2; ++sl) { const int row = sl ? row1 : row0, L = (row >> 8) * 4 + j;
                        if (L >= tailL) { const bf16* pp = PBp + ((size_t)(L - tailL) * 256 + (row & 255)) * 256 + 4 * lane;
                            for (int ks = 1; ks < tailS; ++ks) { const u32x2 p = *(const u32x2*)(pp + (size_t)ks * 128 * 65536); y[j][0] += bf2f(p.x & 0xffffu); y[j][1] += bf2f(p.x >> 16); y[j][2] += bf2f(p.y & 0xffffu); y[j][3] += bf2f(p.y >> 16); } } }
            }
#pragma unroll
            for (int j = 0; j < 4; ++j) v[j] = v[j] + g2q[j] * y[j];
        }
        if ((from_in || combine) && which != 2) {
#pragma unroll
            for (int j = 0; j < 4; ++j) { u32x2 o; o.x = cvt_pk_bf16(v[j][0], v[j][1]); o.y = cvt_pk_bf16(v[j][2], v[j][3]); *(u32x2*)(XS + (size_t)t * D + 4 * lane + 256 * j) = o;
                v[j][0] = bf2f(o.x & 0xffffu); v[j][1] = bf2f(o.x >> 16); v[j][2] = bf2f(o.y & 0xffffu); v[j][3] = bf2f(o.y >> 16); }
        }
        float ss = 0.f;
#pragma unroll
        for (int j = 0; j < 4; ++j) ss += (v[j][0] * v[j][0] + v[j][1] * v[j][1]) + (v[j][2] * v[j][2] + v[j][3] * v[j][3]);
        const float rstd = rsqrtf(wave_sum(ss) * (1.f / D) + NORM_EPS);
        if (which == 2) {
            float* op = a.out + ((size_t)b * SEQ + (s - CTXL)) * D;
#pragma unroll
            for (int j = 0; j < 4; ++j) *(f32x4*)(op + 4 * lane + 256 * j) = v[j] * rstd * gv[j];
            continue;
        }
        f32x4 hv[4];
#pragma unroll
        for (int j = 0; j < 4; ++j) { const f32x4 shv = shq[j], scv = scq[j];
            hv[j] = (v[j] * rstd * gv[j]) * (scv + 1.f) + shv;
            u32x2 o; o.x = cvt_pk_bf16(hv[j][0], hv[j][1]); o.y = cvt_pk_bf16(hv[j][2], hv[j][3]);
            *(u32x2*)(H + (size_t)t * D + 4 * lane + 256 * j) = o; }
        if (route) {
            float lg[NEXP];
#pragma unroll
            for (int e = 0; e < NEXP; ++e) lg[e] = 0.f;
#pragma unroll
            for (int j = 0; j < 4; ++j)
#pragma unroll
                for (int i = 0; i < 4; ++i) { const float hx = hv[j][i];
#pragma unroll
                    for (int e = 0; e < 4; ++e) { lg[e] += hx * rw[4 * j + i][0][e]; lg[4 + e] += hx * rw[4 * j + i][1][e]; } }
#pragma unroll
            for (int e = 0; e < NEXP; ++e) lg[e] = wave_sum(lg[e]);
            {
                int e0 = 0; float v0 = lg[0];
#pragma unroll
                for (int e = 1; e < NEXP; ++e) if (lg[e] > v0) { v0 = lg[e]; e0 = e; }
                int e1 = -1; float v1 = -3.0e38f;
#pragma unroll
                for (int e = 0; e < NEXP; ++e) if (e != e0 && lg[e] > v1) { v1 = lg[e]; e1 = e; }
                const float w0 = 1.f / (1.f + __expf(v1 - v0));
                if (lane == kq) { pe0 = e0; pe1 = e1; pw0 = w0; pt = t; }
                ++kq;
            }
        }
    }
    if (route) {
        const int lp_ = layer >> 1; unsigned* ctl = (unsigned*)(ws + WS_CTL);
        if (lane < kq) *(int4*)(ws + WS_TOK + (size_t)pt * 16) = make_int4(pe0, pe1, (int)__float_as_uint(pw0), 1);
        unsigned mycnt = 0;
#pragma unroll
        for (int e = 0; e < NEXP; ++e) { const unsigned long long m = __ballot(lane < kq && (pe0 == e || pe1 == e)); if (lane == e) mycnt = (unsigned)__popcll(m); }
        if (lane < NEXP) { ctl[CW_WCNT + lp_ * 16384 + gw * 8 + lane] = mycnt; __hip_atomic_fetch_add(ctl + CW_WGSUM + lp_ * 2048 + bx * 8 + lane, mycnt, __ATOMIC_RELAXED, __HIP_MEMORY_SCOPE_AGENT); }
    }
}

DI void route_assign_phase(unsigned char* ws, int layer, int G, int bx) {
    int tid = threadIdx.x; asm volatile("" : "+v"(tid));
    const int lane = tid & 63, wave = __builtin_amdgcn_readfirstlane(tid >> 6), gw = bx * NWAVES + wave, NGW = G * NWAVES, lp_ = layer >> 1;
    const unsigned* ctl = (const unsigned*)(ws + WS_CTL); const unsigned* wgs = ctl + CW_WGSUM + lp_ * 2048; const unsigned* wcn = ctl + CW_WCNT + lp_ * 16384;
    unsigned base[NEXP];
#pragma unroll
    for (int e = 0; e < NEXP; ++e) base[e] = 0u;
    {
        unsigned cw_[5][NEXP];
#pragma unroll
        for (int k = 0; k < 4; ++k) { const int w = lane + 64 * k; const bool on = w < bx; const int wc_ = on ? w : 0;
#pragma unroll
            for (int e = 0; e < NEXP; ++e) { const unsigned x = __hip_atomic_load(wgs + wc_ * 8 + e, __ATOMIC_RELAXED, __HIP_MEMORY_SCOPE_AGENT); cw_[k][e] = on ? x : 0u; } }
        { const bool on = lane < wave; const int li = on ? lane : 0;
#pragma unroll
            for (int e = 0; e < NEXP; ++e) { const unsigned x = __hip_atomic_load(wcn + (bx * NWAVES + li) * 8 + e, __ATOMIC_RELAXED, __HIP_MEMORY_SCOPE_AGENT); cw_[4][e] = on ? x : 0u; } }
#pragma unroll
        for (int e = 0; e < NEXP; ++e) base[e] = ((cw_[0][e] + cw_[1][e]) + (cw_[2][e] + cw_[3][e])) + cw_[4][e];
    }
    for (int w = lane + 256; w < bx; w += 64) {
#pragma unroll
        for (int e = 0; e < NEXP; ++e) base[e] += __hip_atomic_load(wgs + w * 8 + e, __ATOMIC_RELAXED, __HIP_MEMORY_SCOPE_AGENT); }
#pragma unroll
    for (int e = 0; e < NEXP; ++e) {
        base[e] = wave_sum_u(base[e]); }
    const int CH = (T + NGW - 1) / NGW, t = gw * CH + lane; const int s_ = t % LT;
    const bool valid = lane < CH && t < T && !(layer == 3 && s_ < CTXL);
    int4 tk = make_int4(0, 0, 0, 0); if (valid) tk = *(const int4*)(ws + WS_TOK + (size_t)t * 16);
    const int e0 = valid ? tk.x : -1, e1 = valid ? tk.y : -1; int p0 = 0, p1 = 0; unsigned tot = 0;
    const unsigned long long ltm = (lane == 0) ? 0ull : (~0ull >> (64 - lane));
#pragma unroll
    for (int e = 0; e < NEXP; ++e) { const unsigned long long m = __ballot(e0 == e || e1 == e); const int rank = __popcll(m & ltm);
        if (e0 == e) p0 = (int)base[e] + rank; if (e1 == e) p1 = (int)base[e] + rank; if (lane == e) tot = base[e] + (unsigned)__popcll(m); }
    if (valid) { const float w0 = __uint_as_float((unsigned)tk.z); int* list = (int*)(ws + WS_LIST); float* gwt = (float*)(ws + WS_GW);
        list[(size_t)e0 * T + p0] = t; gwt[(size_t)e0 * T + p0] = w0; list[(size_t)e1 * T + p1] = t; gwt[(size_t)e1 * T + p1] = 1.f - w0;
        *(int4*)(ws + WS_TOK + (size_t)t * 16) = make_int4(e0, p0, e1, p1); }
    if (gw == NGW - 1 && lane < NEXP) ((unsigned*)(ws + WS_CTL))[CW_CNT + (lp_ * 8 + lane) * 64] = tot;
    if (gw == NGW - 1) {
        int* list = (int*)(ws + WS_LIST); float* gwt = (float*)(ws + WS_GW);
#pragma unroll
        for (int e = 0; e < NEXP; ++e) { const int c = __builtin_amdgcn_readlane((int)tot, e); for (int p = c + lane; p < ((c + 255) & ~255); p += 64) { list[(size_t)e * T + p] = 0; gwt[(size_t)e * T + p] = 0.f; } } }
}

DI void unpack8(const u32x4& p, float (&f)[8]) { f[0] = bf2f(p.x & 0xffffu); f[1] = bf2f(p.x >> 16); f[2] = bf2f(p.y & 0xffffu); f[3] = bf2f(p.y >> 16); f[4] = bf2f(p.z & 0xffffu); f[5] = bf2f(p.z >> 16); f[6] = bf2f(p.w & 0xffffu); f[7] = bf2f(p.w >> 16); }
DI void even_mid_phase(const Args& a, unsigned char* ws, int layer, int G, int bx) {
    int tid = threadIdx.x; asm volatile("" : "+v"(tid));
    const int lane = tid & 63, wave = __builtin_amdgcn_readfirstlane(tid >> 6), gw = bx * NWAVES + wave, NGW = G * NWAVES, gtid = bx * NTHR + tid, NGT = G * NTHR;
    (void)lane; (void)wave; (void)gw; (void)NGW; (void)gtid; (void)NGT;
    const bf16* P = (const bf16*)(ws + WS_R0 + RE_P); bf16* MIX = (bf16*)(ws + WS_R0 + RE_MIX); bf16* A2 = (bf16*)(ws + WS_R0 + RE_A2); bf16* KR = (bf16*)(ws + WS_KR);
    const float* ropec = (const float*)(ws + WS_ROPE); const float* ropes = ropec + 2048 * 16;
    const float* cw = a.in[LIN(layer, 4)]; const float* qg = a.in[LIN(layer, 5)]; const float* kg = a.in[LIN(layer, 7)];
    float w0[8], w1[8], w2[8];
#pragma unroll
    for (int i = 0; i < 8; ++i) { w0[i] = cw[8 * lane + i]; w1[i] = cw[512 + 8 * lane + i]; w2[i] = cw[1024 + 8 * lane + i]; }
    const f32x4 qgv = *(const f32x4*)(qg + 4 * lane); const f32x2 kgv = *(const f32x2*)(kg + 2 * lane);
    struct Row { u32x4 gb, x0, x1; u32x2 cq; unsigned ckv; unsigned short ka, kb; float rc, rsn; };
    const int li = lane & 15, oa = li < 8 ? li : 8 + li, ob = li < 8 ? 8 + li : 16 + li;
#define EM_LOAD(dst, tt) do { const int t_ = (tt) < 0 ? 0 : ((tt) > T - 1 ? T - 1 : (tt)); const bf16* p_ = P + (size_t)t_ * EVEN_INP; const int s_ = t_ % LT, sr_ = s_ >= CTXL ? s_ - CTXL : 0; \
        dst.gb = *(const u32x4*)(p_ + 8 * lane); dst.x0 = *(const u32x4*)(p_ + 512 + 8 * lane); dst.x1 = *(const u32x4*)(p_ + 1024 + 8 * lane); dst.cq = *(const u32x2*)(p_ + 1536 + 4 * lane); \
        dst.ckv = *(const unsigned*)(p_ + 1792 + 2 * lane); dst.ka = *(const unsigned short*)(p_ + 1920 + oa); dst.kb = *(const unsigned short*)(p_ + 1920 + ob); \
        dst.rc = ropec[(size_t)sr_ * 16 + li]; dst.rsn = ropes[(size_t)sr_ * 16 + li]; } while (0)
    const int CH = (T + NGW - 1) / NGW, tA = gw * CH, tE = (tA + CH < T) ? tA + CH : T;
    Row r0, r1, r2; float pm[8];
#pragma unroll
    for (int i = 0; i < 8; ++i) pm[i] = 0.f;
    if (tA < tE) { Row rm; EM_LOAD(rm, tA - 1); EM_LOAD(r0, tA); EM_LOAD(r1, tA + 1); float a0[8], a1[8]; unpack8(rm.x0, a0); unpack8(rm.x1, a1);
#pragma unroll
        for (int i = 0; i < 8; ++i) pm[i] = a0[i] * a1[i]; }
#pragma unroll 1
    for (int t = tA; t < tE; ++t) {
        const int s = t % LT; const bool hp = (s != 0 && s != CTXL), hn = (s != CTXL - 1 && s != LT - 1);
        EM_LOAD(r2, t + 2);
        float gb[8], x0[8], x1[8], y[8], p0[8];
        unpack8(r0.gb, gb); unpack8(r0.x0, x0); unpack8(r0.x1, x1);
#pragma unroll
        for (int i = 0; i < 8; ++i) { p0[i] = x0[i] * x1[i]; y[i] = w1[i] * p0[i]; }
        if (hp) {
#pragma unroll
            for (int i = 0; i < 8; ++i) y[i] += w0[i] * pm[i]; }
        unpack8(r1.x0, x0); unpack8(r1.x1, x1);
        if (hn) {
#pragma unroll
            for (int i = 0; i < 8; ++i) y[i] += w2[i] * (x0[i] * x1[i]); }
        { u32x4 o; o.x = cvt_pk_bf16(gb[0] * y[0], gb[1] * y[1]); o.y = cvt_pk_bf16(gb[2] * y[2], gb[3] * y[3]); o.z = cvt_pk_bf16(gb[4] * y[4], gb[5] * y[5]); o.w = cvt_pk_bf16(gb[6] * y[6], gb[7] * y[7]);
          *(u32x4*)(MIX + (size_t)t * D + 8 * lane) = o; }
        { const u32x2 p = r0.cq; const float c0 = bf2f(p.x & 0xffffu), c1 = bf2f(p.x >> 16), c2 = bf2f(p.y & 0xffffu), c3 = bf2f(p.y >> 16);
          const float rs = rsqrtf(wave_sum((c0 * c0 + c1 * c1) + (c2 * c2 + c3 * c3)) * (1.f / 256.f) + NORM_EPS);
          u32x2 o; o.x = cvt_pk_bf16(c0 * rs * qgv[0], c1 * rs * qgv[1]); o.y = cvt_pk_bf16(c2 * rs * qgv[2], c3 * rs * qgv[3]); *(u32x2*)(A2 + (size_t)t * UP_K + 4 * lane) = o; }
        { const unsigned p = r0.ckv; const float c0 = bf2f(p & 0xffffu), c1 = bf2f(p >> 16);
          const float rs = rsqrtf(wave_sum(c0 * c0 + c1 * c1) * (1.f / 128.f) + NORM_EPS);
          *(unsigned*)(A2 + (size_t)t * UP_K + 256 + 2 * lane) = cvt_pk_bf16(c0 * rs * kgv[0], c1 * rs * kgv[1]); }
        if (lane < 16) { const float av = bf2f((unsigned)r0.ka), bv = bf2f((unsigned)r0.kb); float ra = av, rb = bv;
            if (s >= CTXL) { ra = av * r0.rc - bv * r0.rsn; rb = bv * r0.rc + av * r0.rsn; }
            *(unsigned*)(KR + (size_t)t * 32 + 2 * lane) = cvt_pk_bf16(ra, rb); }
#pragma unroll
        for (int i = 0; i < 8; ++i) pm[i] = p0[i];
        r0 = r1; r1 = r2;
    }
#undef EM_LOAD
}

DI void odd_mid_phase(const Args& a, unsigned char* ws, int layer, LAS unsigned char* lds, int G, int bx) {
    int tid = threadIdx.x; asm volatile("" : "+v"(tid));
    const int lane = tid & 63, wave = __builtin_amdgcn_readfirstlane(tid >> 6), gw = bx * NWAVES + wave, NGW = G * NWAVES, gtid = bx * NTHR + tid, NGT = G * NTHR;
    (void)lane; (void)wave; (void)gw; (void)NGW; (void)gtid; (void)NGT;
    const bf16* QR = (const bf16*)(ws + WS_R0); bf16* QN = (bf16*)(ws + WS_R1); const float* AB = (const float*)(ws + WS_AB); float* GB = (float*)(ws + WS_GB);
    LAS float* cwl = (LAS float*)lds;
    { const float* cw = a.in[LIN(layer, 4)]; for (int i = tid; i < 3 * 3072; i += NTHR) cwl[i] = cw[i]; }
    __syncthreads();
    const float* alog = a.in[LIN(layer, 5)]; const float* dtb = a.in[LIN(layer, 6)];
    float Aexp = 0.f, dtv = 0.f; if (lane < 16) { Aexp = __expf(alog[lane]); dtv = dtb[lane]; }
    const int CH = (T + NGW - 1) / NGW, tA = gw * CH, tE = (tA + CH < T) ? tA + CH : T;
    u32x4 rm[6], r0[6], rp[6], rq[6]; float abv = 0.f, abt = 0.f, abvn = 0.f, abtn = 0.f;
#define OM_LOAD(dst, tt) do { const int t_ = (tt) < 0 ? 0 : ((tt) > T - 1 ? T - 1 : (tt)); const bf16* p_ = QR + (size_t)t_ * 3072 + 8 * lane; _Pragma("unroll") for (int g = 0; g < 6; ++g) dst[g] = *(const u32x4*)(p_ + 512 * g); } while (0)
    if (tA < tE) { OM_LOAD(rm, tA - 1); OM_LOAD(r0, tA); OM_LOAD(rp, tA + 1); if (lane < 16) { abv = AB[(size_t)tA * 32 + lane]; abt = AB[(size_t)tA * 32 + 16 + lane]; } }
#pragma unroll 1
    for (int t = tA; t < tE; ++t) {
        const int s = t % LT; const bool hp = (s != 0 && s != CTXL), hn = (s != CTXL - 1 && s != LT - 1);
        OM_LOAD(rq, t + 2);
        if (lane < 16) { const int tn = t + 1 < T ? t + 1 : t; abvn = AB[(size_t)tn * 32 + lane]; abtn = AB[(size_t)tn * 32 + 16 + lane]; }
        const float mp = hp ? 1.f : 0.f, mn = hn ? 1.f : 0.f;
        int lz_ = lane; asm volatile("" : "+v"(lz_));
#pragma unroll
        for (int g = 0; g < 6; ++g) { const int c = 8 * lz_ + 512 * g; float xm[8], x0[8], xp[8], val[8];
            unpack8(rm[g], xm); unpack8(r0[g], x0); unpack8(rp[g], xp);
            const f32x4 wa0 = *(const LAS f32x4*)(cwl + c), wa1 = *(const LAS f32x4*)(cwl + c + 4), wb0 = *(const LAS f32x4*)(cwl + 3072 + c), wb1 = *(const LAS f32x4*)(cwl + 3072 + c + 4), wc0 = *(const LAS f32x4*)(cwl + 6144 + c), wc1 = *(const LAS f32x4*)(cwl + 6144 + c + 4);
#pragma unroll
            for (int i = 0; i < 8; ++i) { const float wA = i < 4 ? wa0[i & 3] : wa1[i & 3], wB = i < 4 ? wb0[i & 3] : wb1[i & 3], wC = i < 4 ? wc0[i & 3] : wc1[i & 3];
                const float y = wA * xm[i] * mp + wB * x0[i] + wC * xp[i] * mn; val[i] = silu_f(y); }
            if (g < 4) { float ss = 0.f;
#pragma unroll
                for (int i = 0; i < 8; ++i) ss += val[i] * val[i];
                ss = sum16(ss);
                const float rs = rsqrtf(ss + NORM_EPS) * (g < 2 ? 0.08838834764831845f : 1.f);
#pragma unroll
                for (int i = 0; i < 8; ++i) val[i] *= rs; }
            u32x4 o; o.x = cvt_pk_bf16(val[0], val[1]); o.y = cvt_pk_bf16(val[2], val[3]); o.z = cvt_pk_bf16(val[4], val[5]); o.w = cvt_pk_bf16(val[6], val[7]);
            *(u32x4*)(QN + (size_t)t * 3072 + 8 * lane + 512 * g) = o; }
        if (lane < 16) { const float z = abv + dtv;
            const float sp = z > 20.f ? z : log1pf(__expf(z));
            GB[(size_t)t * 32 + lane] = -Aexp * sp; GB[(size_t)t * 32 + 16 + lane] = 1.f / (1.f + __expf(-abt)); }
#pragma unroll
        for (int g = 0; g < 6; ++g) { rm[g] = r0[g]; r0[g] = rp[g]; rp[g] = rq[g]; }
        abv = abvn; abt = abtn;
    }
#undef OM_LOAD
    __syncthreads();
}

DI void odd_post_phase(const Args& a, unsigned char* ws, int layer, int G, int bx) {
    int tid = threadIdx.x; asm volatile("" : "+v"(tid));
    const int lane = tid & 63, wave = __builtin_amdgcn_readfirstlane(tid >> 6), gw = bx * NWAVES + wave, NGW = G * NWAVES, gtid = bx * NTHR + tid, NGT = G * NTHR;
    (void)lane; (void)wave; (void)gw; (void)NGW; (void)gtid; (void)NGT;
    const bf16* OF = (const bf16*)(ws + WS_R1); const bf16* OB = OF + (size_t)T * D; bf16* Y = (bf16*)(ws + WS_R1) + (size_t)2 * T * D; const bf16* GATE = (const bf16*)(ws + WS_R2);
    const float* og = a.in[LIN(layer, 7)];
    float gg[16];
#pragma unroll
    for (int i = 0; i < 16; ++i) gg[i] = og[(16 * lane + i) & 127];
    for (int t = gw; t < T; t += NGW) {
        const size_t off = (size_t)t * D + 16 * lane; float o[16], f0[8], f1[8];
        unpack8(*(const u32x4*)(OF + off), f0); unpack8(*(const u32x4*)(OB + off), f1);
#pragma unroll
        for (int i = 0; i < 8; ++i) o[i] = f0[i] + f1[i];
        unpack8(*(const u32x4*)(OF + off + 8), f0); unpack8(*(const u32x4*)(OB + off + 8), f1);
#pragma unroll
        for (int i = 0; i < 8; ++i) o[8 + i] = f0[i] + f1[i];
        float ss = 0.f;
#pragma unroll
        for (int i = 0; i < 16; ++i) ss += o[i] * o[i];
        ss = sum8(ss);
        const float rs = rsqrtf(ss * (1.f / 128.f) + NORM_EPS);
        unpack8(*(const u32x4*)(GATE + off), f0); unpack8(*(const u32x4*)(GATE + off + 8), f1);
        float y[16];
#pragma unroll
        for (int i = 0; i < 8; ++i) { y[i] = o[i] * rs * gg[i] * silu_f(f0[i]); y[8 + i] = o[8 + i] * rs * gg[8 + i] * silu_f(f1[i]); }
        u32x4 q0, q1; q0.x = cvt_pk_bf16(y[0], y[1]); q0.y = cvt_pk_bf16(y[2], y[3]); q0.z = cvt_pk_bf16(y[4], y[5]); q0.w = cvt_pk_bf16(y[6], y[7]);
        q1.x = cvt_pk_bf16(y[8], y[9]); q1.y = cvt_pk_bf16(y[10], y[11]); q1.z = cvt_pk_bf16(y[12], y[13]); q1.w = cvt_pk_bf16(y[14], y[15]);
        *(u32x4*)(Y + off) = q0; *(u32x4*)(Y + off + 8) = q1;
    }
}

constexpr int AT_KSTR = 208, AT_VSTR = 272, AT_KBYTES = 128 * AT_KSTR, AT_VBYTES = 64 * AT_VSTR, AT_BUF = AT_KBYTES + AT_VBYTES;
DI bf16x8 pack_frag(const f32x4& lo, const f32x4& hi) { u32x4 w = pack8(lo, hi); return __builtin_bit_cast(bf16x8, w); }
DI void attn_phase(unsigned char* ws, LAS unsigned char* lds, int G, int bx) {
    int tid = threadIdx.x; asm volatile("" : "+v"(tid));
    const int lane = tid & 63, wave = __builtin_amdgcn_readfirstlane(tid >> 6);
    const bf16* Q = (const bf16*)(ws + WS_R0 + RE_Q); const bf16* KN = (const bf16*)(ws + WS_R0 + RE_KN); const bf16* VT = (const bf16*)(ws + WS_R0 + RE_VT); const bf16* KR = (const bf16*)(ws + WS_KR);
    bf16* MIX = (bf16*)(ws + WS_R0 + RE_MIX);
    const int fr = lane & 15, fq = lane >> 4;
    const int vcu = (G % 8 == 0) ? (bx & 7) * (G >> 3) + (bx >> 3) : bx;
    for (int L = vcu; L < 576; L += G) {
        int b, h, q0, nk;
        if (L < 512) { b = L >> 6; h = (L >> 3) & 7; q0 = CTXL + (L & 7) * 256; nk = LT; } else { const int r = L - 512; b = r >> 3; h = r & 7; q0 = 0; nk = CTXL; }
        const int ntile = nk / 128; const size_t tb = (size_t)b * LT;
        bf16x8 qf[2][3];
#pragma unroll
        for (int qb = 0; qb < 2; ++qb)
#pragma unroll
            for (int ks = 0; ks < 3; ++ks) qf[qb][ks] = *(const bf16x8*)(Q + (tb + q0 + wave * 32 + qb * 16 + fr) * 768 + h * 96 + ks * 32 + fq * 8);
        f32x4 ot[4][2];
#pragma unroll
        for (int d = 0; d < 4; ++d)
#pragma unroll
            for (int qb = 0; qb < 2; ++qb) ot[d][qb] = (f32x4){0.f, 0.f, 0.f, 0.f};
        float mrow[2] = {0.f, 0.f}, lrow[2] = {0.f, 0.f};
        const int krow = tid >> 3, kch = tid & 7, rrow = tid >> 2, rch = tid & 3, vrow = tid >> 4, vch = tid & 15;
        const bf16* kn_p = KN + (tb + krow) * 512 + h * 64 + kch * 8; const bf16* kr_p = KR + (tb + rrow) * 32 + rch * 8; const bf16* vt_p = VT + ((size_t)(b * 8 + h) * 64 + vrow) * LT + vch * 8;
        u32x4 sk0, sk1, sr, sv0, sv1;
#define AT_LOAD(t_) do { const size_t ko_ = (size_t)(t_) * 128; sk0 = *(const u32x4*)(kn_p + ko_ * 512); sk1 = *(const u32x4*)(kn_p + (ko_ + 64) * 512); sr = *(const u32x4*)(kr_p + ko_ * 32); \
        sv0 = *(const u32x4*)(vt_p + ko_); sv1 = *(const u32x4*)(vt_p + (size_t)32 * LT + ko_); } while (0)
#define AT_WRITE(bb_) do { LAS unsigned char* b2_ = (bb_); *(LAS u32x4*)(b2_ + krow * AT_KSTR + kch * 16) = sk0; *(LAS u32x4*)(b2_ + (krow + 64) * AT_KSTR + kch * 16) = sk1; *(LAS u32x4*)(b2_ + rrow * AT_KSTR + 128 + rch * 16) = sr; \
        *(LAS u32x4*)(b2_ + AT_KBYTES + vrow * AT_VSTR + vch * 16) = sv0; *(LAS u32x4*)(b2_ + AT_KBYTES + (vrow + 32) * AT_VSTR + vch * 16) = sv1; } while (0)
        AT_LOAD(0); AT_WRITE(lds);
        __syncthreads();
        for (int kt = 0; kt < ntile; ++kt) {
            const bool more = kt + 1 < ntile;
            if (more) AT_LOAD(kt + 1);
            const LAS unsigned char* kb = lds + (kt & 1) * AT_BUF; const LAS unsigned char* vb = kb + AT_KBYTES;
            f32x4 st[8][2];
#pragma unroll
            for (int k4 = 0; k4 < 8; ++k4) {
                bf16x8 kf[3];
#pragma unroll
                for (int ks = 0; ks < 3; ++ks) kf[ks] = *(const LAS bf16x8*)(kb + (k4 * 16 + fr) * AT_KSTR + ks * 64 + fq * 16);
#pragma unroll
                for (int qb = 0; qb < 2; ++qb) { const float nm = -mrow[qb]; f32x4 acc = (f32x4){nm, nm, nm, nm};
#pragma unroll
                    for (int ks = 0; ks < 3; ++ks) acc = __builtin_amdgcn_mfma_f32_16x16x32_bf16(kf[ks], qf[qb][ks], acc, 0, 0, 0);
                    st[k4][qb] = acc; }
            }
            bf16x8 pb[2][4];
            int imx[2];
#pragma unroll
            for (int qb = 0; qb < 2; ++qb) {
                int mi = max(max(__float_as_int(st[0][qb][0]), __float_as_int(st[0][qb][1])), max(__float_as_int(st[0][qb][2]), __float_as_int(st[0][qb][3])));
#pragma unroll
                for (int k4 = 1; k4 < 8; ++k4) { mi = max(max(mi, __float_as_int(st[k4][qb][0])), __float_as_int(st[k4][qb][1])); mi = max(max(mi, __float_as_int(st[k4][qb][2])), __float_as_int(st[k4][qb][3])); }
                imx[qb] = mi;
            }
            if (__any((kt == 0) || (max(imx[0], imx[1]) > __float_as_int(8.f)))) {
                float mxr[2];
#pragma unroll
                for (int qb = 0; qb < 2; ++qb) {
                    float mx = fmaxf(fmaxf(st[0][qb][0], st[0][qb][1]), fmaxf(st[0][qb][2], st[0][qb][3]));
#pragma unroll
                    for (int k4 = 1; k4 < 8; ++k4) mx = fmaxf(mx, fmaxf(fmaxf(st[k4][qb][0], st[k4][qb][1]), fmaxf(st[k4][qb][2], st[k4][qb][3])));
                    mx = fmaxf(mx, __shfl_xor(mx, 16)); mxr[qb] = fmaxf(mx, __shfl_xor(mx, 32));
                }
#pragma unroll
                for (int qb = 0; qb < 2; ++qb) { const float delta = (kt == 0) ? mxr[qb] : fmaxf(mxr[qb], 0.f), alpha = __builtin_amdgcn_exp2f(-delta);
                    mrow[qb] += delta; lrow[qb] *= alpha;
#pragma unroll
                    for (int d = 0; d < 4; ++d) ot[d][qb] = ot[d][qb] * alpha;
#pragma unroll
                    for (int k4 = 0; k4 < 8; ++k4) st[k4][qb] = st[k4][qb] - delta; }
            }
#pragma unroll
            for (int hf = 0; hf < 2; ++hf) {
#pragma unroll
                for (int qb = 0; qb < 2; ++qb) {
                    float rs = 0.f;
#pragma unroll
                    for (int k4 = 4 * hf; k4 < 4 * hf + 4; ++k4)
#pragma unroll
                        for (int j = 0; j < 4; ++j) { const float p = __builtin_amdgcn_exp2f(st[k4][qb][j]); st[k4][qb][j] = p; rs += p; }
                    lrow[qb] += rs;
#pragma unroll
                    for (int ks = 2 * hf; ks < 2 * hf + 2; ++ks) pb[qb][ks] = pack_frag(st[2 * ks][qb], st[2 * ks + 1][qb]);
                }
#pragma unroll
                for (int d = 0; d < 4; ++d)
#pragma unroll
                    for (int ks = 2 * hf; ks < 2 * hf + 2; ++ks) {
                        const u32x2 lo = *(const LAS u32x2*)(vb + (d * 16 + fr) * AT_VSTR + (ks * 32 + fq * 4) * 2), hi = *(const LAS u32x2*)(vb + (d * 16 + fr) * AT_VSTR + (ks * 32 + 16 + fq * 4) * 2);
                        const u32x4 vv = (u32x4){lo.x, lo.y, hi.x, hi.y}; const bf16x8 vf = __builtin_bit_cast(bf16x8, vv);
#pragma unroll
                        for (int qb = 0; qb < 2; ++qb) ot[d][qb] = __builtin_amdgcn_mfma_f32_16x16x32_bf16(vf, pb[qb][ks], ot[d][qb], 0, 0, 0);
                    }
            }
            if (more) AT_WRITE(lds + ((kt + 1) & 1) * AT_BUF);
            __syncthreads();
        }
#undef AT_LOAD
#undef AT_WRITE
#pragma unroll
        for (int qb = 0; qb < 2; ++qb) {
            float l = lrow[qb]; l += __shfl_xor(l, 16); l += __shfl_xor(l, 32); const float inv = 1.f / l;
            bf16* op = MIX + (tb + q0 + wave * 32 + qb * 16 + fr) * D + 512 + h * 64 + fq * 4;
#pragma unroll
            for (int d = 0; d < 4; ++d) { u32x2 o; o.x = cvt_pk_bf16(ot[d][qb][0] * inv, ot[d][qb][1] * inv); o.y = cvt_pk_bf16(ot[d][qb][2] * inv, ot[d][qb][3] * inv); *(u32x2*)(op + d * 16) = o; }
        }
    }
}

constexpr int CLQ = 0, CLK = 17408, CLV = 34816, CLKK = 52224, CLQK = 68864, CLLN = 85504  , CLLD = 102912  ,
              CLDI = 111104  , CLG = 116224;
DI int kperm(int ks, int fq, int j) { return 32 * ks + 16 * (j >> 2) + 4 * fq + (j & 3); }
DI bf16x8 frag_lo(const u32x2 v) { const u32x4 w = (u32x4){v.x, v.y, 0u, 0u}; return __builtin_bit_cast(bf16x8, w); }
DI bf16x8 frag_lh(const u32x2 a, const u32x2 b) { const u32x4 w = (u32x4){a.x, a.y, b.x, b.y}; return __builtin_bit_cast(bf16x8, w); }
DI void gdn_chunk_phase(unsigned char* ws, LAS unsigned char* lds, int G, int bx) {
    const bf16* QN = (const bf16*)(ws + WS_R1); const float* GB = (const float*)(ws + WS_GB); unsigned char* CL = ws + WS_R0; float* GEND = (float*)(ws + WS_GEND);
    LAS float* KKs = (LAS float*)(lds + CLKK); LAS float* QKs = (LAS float*)(lds + CLQK); LAS float* gcs = (LAS float*)(lds + CLG);
    u32x4 pre[3][2]; float pg[4] = {0.f, 0.f, 0.f, 0.f};
    { int tid0 = threadIdx.x; asm volatile("" : "+v"(tid0));
      if (bx < NB * 8 * 36) { const int u = bx, b = u / 288, h = (u / 36) & 7, blk = u % 36; const size_t t0 = (size_t)b * LT + blk * 64;
#pragma unroll
        for (int mtx = 0; mtx < 3; ++mtx)
#pragma unroll
            for (int i = 0; i < 2; ++i) { const int id = tid0 + 512 * i, row = id >> 4, ch = id & 15; pre[mtx][i] = *(const u32x4*)(QN + (t0 + row) * 3072 + mtx * 1024 + h * 128 + ch * 8); }
        if (tid0 < 64) { const float* gp = GB + (t0 + tid0) * 32; pg[0] = gp[h]; pg[1] = gp[8 + h]; pg[2] = gp[16 + h]; pg[3] = gp[24 + h]; } } }
    for (int u = bx; u < NB * 8 * 36; u += G) {
        int tid = threadIdx.x; asm volatile("" : "+v"(tid));
        const int lane = tid & 63, wave = __builtin_amdgcn_readfirstlane(tid >> 6), fr = lane & 15, fq = lane >> 4;
        const int b = u / 288, h = (u / 36) & 7, blk = u % 36;
#pragma unroll
        for (int mtx = 0; mtx < 3; ++mtx)
#pragma unroll
            for (int i = 0; i < 2; ++i) { const int id = tid + 512 * i, row = id >> 4, ch = id & 15; *(LAS u32x4*)(lds + mtx * 17408 + row * 272 + ch * 16) = pre[mtx][i]; }
        if (wave == 0) { float gf = pg[0], gb = pg[1]; const float bf_ = pg[2], bb_ = pg[3];
            { const float xb = gb, pb_ = wave_scan_incl(gb); gf = wave_scan_incl(gf);
              const float totb = __builtin_bit_cast(float, __builtin_amdgcn_readlane(__builtin_bit_cast(int, pb_), 63)); gb = (totb - pb_) + xb; }
            const float ef = __expf(gf), eb = __expf(gb); gcs[lane] = gf; gcs[64 + lane] = gb; gcs[128 + lane] = bf_; gcs[192 + lane] = bb_; gcs[256 + lane] = bf_ * ef; gcs[320 + lane] = bb_ * eb; gcs[384 + lane] = ef; gcs[448 + lane] = eb;
            const float glf = __builtin_bit_cast(float, __builtin_amdgcn_readlane(__builtin_bit_cast(int, gf), 63)), glb = __builtin_bit_cast(float, __builtin_amdgcn_readlane(__builtin_bit_cast(int, gb), 0)); gcs[512 + lane] = __expf(glf - gf); gcs[576 + lane] = __expf(glb - gb); }
        if (u + G < NB * 8 * 36) { const int un = u + G, bn = un / 288, hn = (un / 36) & 7, blkn = un % 36; const size_t t0n = (size_t)bn * LT + blkn * 64;
#pragma unroll
            for (int mtx = 0; mtx < 3; ++mtx)
#pragma unroll
                for (int i = 0; i < 2; ++i) { const int id = tid + 512 * i, row = id >> 4, ch = id & 15; pre[mtx][i] = *(const u32x4*)(QN + (t0n + row) * 3072 + mtx * 1024 + hn * 128 + ch * 8); }
            if (wave == 0) { const float* gp = GB + (t0n + lane) * 32; pg[0] = gp[hn]; pg[1] = gp[8 + hn]; pg[2] = gp[16 + hn]; pg[3] = gp[24 + hn]; } }
        __syncthreads();
        { const int rb = wave & 3; const bool iskk = wave < 4; const LAS unsigned char* Am = lds + (iskk ? CLK : CLQ);
          bf16x8 af[4];
#pragma unroll
          for (int ks = 0; ks < 4; ++ks) af[ks] = *(const LAS bf16x8*)(Am + (rb * 16 + fr) * 272 + ks * 64 + fq * 16);
          float gfi[4], gbi[4], bfi[4], bbi[4];
#pragma unroll
          for (int j = 0; j < 4; ++j) { const int si = rb * 16 + fq * 4 + j; gfi[j] = gcs[si]; gbi[j] = gcs[64 + si]; bfi[j] = gcs[128 + si]; bbi[j] = gcs[192 + si]; }
#pragma unroll
          for (int cb = 0; cb < 4; ++cb) { f32x4 acc = (f32x4){0.f, 0.f, 0.f, 0.f};
#pragma unroll
              for (int ks = 0; ks < 4; ++ks) { const bf16x8 bfr = *(const LAS bf16x8*)(lds + CLK + (cb * 16 + fr) * 272 + ks * 64 + fq * 16); acc = __builtin_amdgcn_mfma_f32_16x16x32_bf16(af[ks], bfr, acc, 0, 0, 0); }
              if (!iskk) {
#pragma unroll
                  for (int j = 0; j < 4; ++j) QKs[(rb * 16 + fq * 4 + j) * 65 + cb * 16 + fr] = acc[j];
              } else { const int sj = cb * 16 + fr; const float gfj = gcs[sj], gbj = gcs[64 + sj];
#pragma unroll
                  for (int j = 0; j < 4; ++j) { const int si = rb * 16 + fq * 4 + j; const float kk = acc[j];
                      const float vf = (sj < si) ? bfi[j] * kk * __expf(fminf(gfi[j] - gfj, 0.f)) : 0.f;
                      const float vb = (sj > si) ? bbi[j] * kk * __expf(fminf(gbi[j] - gbj, 0.f)) : 0.f;
                      *(LAS unsigned short*)(lds + CLLN + si * 136 + sj * 2) = (unsigned short)f2bf(-vf);
                      *(LAS unsigned short*)(lds + CLLN + 8704 + (63 - si) * 136 + (63 - sj) * 2) = (unsigned short)f2bf(-vb);
                      if (cb == rb) { ((LAS float*)(lds + CLLD))[((0 * 4 + rb) * 16 + (si & 15)) * 16 + (sj & 15)] = vf;
                                      ((LAS float*)(lds + CLLD))[((1 * 4 + (3 - rb)) * 16 + ((63 - si) & 15)) * 16 + ((63 - sj) & 15)] = vb; } } } } }
        __syncthreads();
        if (wave < 2) {
            const int r = lane >> 4, c = lane & 15; const LAS float* Lb = (const LAS float*)(lds + CLLD) + (wave * 4 + r) * 256;
            float y[16];
#pragma unroll
            for (int i = 0; i < 16; ++i) { float acc = (i == c) ? 1.f : 0.f;
#pragma unroll
                for (int c4 = 0; c4 < (i + 3) / 4; ++c4) { const f32x4 lv = *(const LAS f32x4*)(Lb + i * 16 + c4 * 4);
#pragma unroll
                    for (int jj = 0; jj < 4; ++jj) if (c4 * 4 + jj < i) acc -= lv[jj] * y[c4 * 4 + jj]; }
                y[i] = acc;
                *(LAS unsigned short*)(lds + CLDI + ((wave * 4 + r) * 16 + i) * 40 + c * 2) = (unsigned short)f2bf(acc); }
        } else {
            const int lfr = lane & 15, lfq = lane >> 4;
            for (int f2 = wave - 2; f2 < 80; f2 += 6) { const int dir = f2 >= 40 ? 1 : 0, f = f2 - 40 * dir, dmk = dir ? 63 : 0;
                unsigned char* dst = CL + (size_t)(((b * 8 + h) * 2 + dir) * 36 + blk) * CL_BYTES; const LAS float* gc = gcs + dir * 64;
                float v[8];
                if (f < 16) { const int rb = f >> 2, ks = f & 3, i = rb * 16 + lfr, s = i ^ dmk; const float e = gcs[384 + dir * 64 + s];
                    const u32x2 lo = *(const LAS u32x2*)(lds + CLQ + s * 272 + (ks * 32 + lfq * 4) * 2), hi = *(const LAS u32x2*)(lds + CLQ + s * 272 + (ks * 32 + 16 + lfq * 4) * 2);
                    v[0] = bf2f(lo.x & 0xffffu) * e; v[1] = bf2f(lo.x >> 16) * e; v[2] = bf2f(lo.y & 0xffffu) * e; v[3] = bf2f(lo.y >> 16) * e; v[4] = bf2f(hi.x & 0xffffu) * e; v[5] = bf2f(hi.x >> 16) * e; v[6] = bf2f(hi.y & 0xffffu) * e; v[7] = bf2f(hi.y >> 16) * e;
                    u32x4 o; o.x = cvt_pk_bf16(v[0], v[1]); o.y = cvt_pk_bf16(v[2], v[3]); o.z = cvt_pk_bf16(v[4], v[5]); o.w = cvt_pk_bf16(v[6], v[7]);
                    *(u32x4*)(dst + CL_QG + (size_t)(f * 64 + lane) * 16) = o;
                } else if (f < 32) { const int g = f - 16, rb = g >> 1, ks = g & 1, dk = rb * 16 + lfr; const LAS float* ekd = gcs + 512 + dir * 64;
#pragma unroll
                    for (int j = 0; j < 8; ++j) { const int s = kperm(ks, lfq, j) ^ dmk; v[j] = bf2f(*(const LAS unsigned short*)(lds + CLK + s * 272 + dk * 2)) * ekd[s]; }
                    u32x4 o; o.x = cvt_pk_bf16(v[0], v[1]); o.y = cvt_pk_bf16(v[2], v[3]); o.z = cvt_pk_bf16(v[4], v[5]); o.w = cvt_pk_bf16(v[6], v[7]);
                    *(u32x4*)(dst + CL_KDT + (size_t)(g * 64 + lane) * 16) = o;
                } else { const int g = f - 32, rb = g >> 1, ks = g & 1, i = rb * 16 + lfr, si = i ^ dmk; const float gi = gc[si];
#pragma unroll
                    for (int j = 0; j < 8; ++j) { const int jj = kperm(ks, lfq, j), sj = jj ^ dmk; v[j] = (jj <= i) ? QKs[si * 65 + sj] * __expf(fminf(gi - gc[sj], 0.f)) : 0.f; }
                    u32x4 o; o.x = cvt_pk_bf16(v[0], v[1]); o.y = cvt_pk_bf16(v[2], v[3]); o.z = cvt_pk_bf16(v[4], v[5]); o.w = cvt_pk_bf16(v[6], v[7]);
                    *(u32x4*)(dst + CL_ATT + (size_t)(g * 64 + lane) * 16) = o; }
            }
            if (tid >= 128 && tid < 130) { const int t2 = tid - 128; GEND[((b * 8 + h) * 2 + t2) * 36 + blk] = t2 ? gcs[448] : gcs[384 + 63]; }
        }
        __syncthreads();
        {
            const f32x4 z4 = (f32x4){0.f, 0.f, 0.f, 0.f};
            f32x4 R[4][4];
#pragma unroll
            for (int q = 0; q < 4; ++q) { const int dir = q >> 1, isw = q & 1, dm = dir ? 63 : 0;
                const LAS unsigned char* Sm = lds + (isw ? CLK : CLV) + (16 * wave + fr) * 2; const LAS float* scp = gcs + 128 + isw * 128 + dir * 64;
#pragma unroll
                for (int r = 0; r < 4; ++r)
#pragma unroll
                    for (int j = 0; j < 4; ++j) { const int s = (16 * r + 4 * fq + j) ^ dm; R[q][r][j] = bf2f(*(const LAS unsigned short*)(Sm + s * 272)) * scp[s]; } }
#define LNP(dir) (lds + CLLN + (dir) * 8704 + fr * 136 + fq * 8)
#define DIP(dir) (lds + CLDI + ((dir) * 4 * 16 + fr) * 40 + fq * 8)
#define DI_FRAG(dir, r) frag_lo(*(const LAS u32x2*)(DIP(dir) + (r) * 640))
#define LN_FRAG2(dir, r, c0, c1) frag_lh(*(const LAS u32x2*)(LNP(dir) + (r) * 2176 + (c0) * 32), *(const LAS u32x2*)(LNP(dir) + (r) * 2176 + (c1) * 32))
#define LN_FRAG1(dir, r, c0) frag_lo(*(const LAS u32x2*)(LNP(dir) + (r) * 2176 + (c0) * 32))
            f32x4 X[4][4]; bf16x8 b01[4];
            { const bf16x8 d0[2] = {DI_FRAG(0, 0), DI_FRAG(1, 0)};
#pragma unroll
              for (int q = 0; q < 4; ++q) X[q][0] = __builtin_amdgcn_mfma_f32_16x16x32_bf16(d0[q >> 1], pack_frag(R[q][0], z4), z4, 0, 0, 0); }
            { const bf16x8 l10[2] = {LN_FRAG1(0, 1, 0), LN_FRAG1(1, 1, 0)}, d1[2] = {DI_FRAG(0, 1), DI_FRAG(1, 1)};
#pragma unroll
              for (int q = 0; q < 4; ++q) R[q][1] = __builtin_amdgcn_mfma_f32_16x16x32_bf16(l10[q >> 1], pack_frag(X[q][0], z4), R[q][1], 0, 0, 0);
#pragma unroll
              for (int q = 0; q < 4; ++q) X[q][1] = __builtin_amdgcn_mfma_f32_16x16x32_bf16(d1[q >> 1], pack_frag(R[q][1], z4), z4, 0, 0, 0); }
#pragma unroll
            for (int q = 0; q < 4; ++q) b01[q] = pack_frag(X[q][0], X[q][1]);
            { const bf16x8 l2[2] = {LN_FRAG2(0, 2, 0, 1), LN_FRAG2(1, 2, 0, 1)}, d2[2] = {DI_FRAG(0, 2), DI_FRAG(1, 2)}, l3[2] = {LN_FRAG2(0, 3, 0, 1), LN_FRAG2(1, 3, 0, 1)};
#pragma unroll
              for (int q = 0; q < 4; ++q) { R[q][2] = __builtin_amdgcn_mfma_f32_16x16x32_bf16(l2[q >> 1], b01[q], R[q][2], 0, 0, 0); R[q][3] = __builtin_amdgcn_mfma_f32_16x16x32_bf16(l3[q >> 1], b01[q], R[q][3], 0, 0, 0); }
#pragma unroll
              for (int q = 0; q < 4; ++q) X[q][2] = __builtin_amdgcn_mfma_f32_16x16x32_bf16(d2[q >> 1], pack_frag(R[q][2], z4), z4, 0, 0, 0); }
            { const bf16x8 l32[2] = {LN_FRAG1(0, 3, 2), LN_FRAG1(1, 3, 2)}, d3[2] = {DI_FRAG(0, 3), DI_FRAG(1, 3)};
#pragma unroll
              for (int q = 0; q < 4; ++q) R[q][3] = __builtin_amdgcn_mfma_f32_16x16x32_bf16(l32[q >> 1], pack_frag(X[q][2], z4), R[q][3], 0, 0, 0);
#pragma unroll
              for (int q = 0; q < 4; ++q) X[q][3] = __builtin_amdgcn_mfma_f32_16x16x32_bf16(d3[q >> 1], pack_frag(R[q][3], z4), z4, 0, 0, 0); }
#undef LNP
#undef DIP
#undef DI_FRAG
#undef LN_FRAG2
#undef LN_FRAG1
#pragma unroll
            for (int q = 0; q < 4; ++q) { const int dir = q >> 1, isw = q & 1;
                unsigned char* dst = CL + (size_t)(((b * 8 + h) * 2 + dir) * 36 + blk) * CL_BYTES;
                if (!isw) {
#pragma unroll
                    for (int r = 0; r < 4; ++r) { u32x2 o; o.x = cvt_pk_bf16(X[q][r][0], X[q][r][1]); o.y = cvt_pk_bf16(X[q][r][2], X[q][r][3]); *(u32x2*)(dst + CL_UT + (size_t)((wave * 4 + r) * 64 + lane) * 8) = o; }
                } else {
                    LAS unsigned char* tp = lds + CLQ + wave * 2048 + (q >> 1) * 1024;
#pragma unroll
                    for (int r = 0; r < 4; ++r) {
#pragma unroll
                        for (int j = 0; j < 4; ++j) *(LAS unsigned short*)(tp + ((r & 1) * 512) + ((4 * fq + j) * 16 + fr) * 2) = (unsigned short)f2bf(X[q][r][j]);
                        LDS_WAIT();
                        const LAS unsigned* rp_ = (const LAS unsigned*)(tp + ((r & 1) * 512) + (fr * 16 + 4 * fq) * 2); u32x2 t8; t8.x = rp_[0]; t8.y = rp_[1];
                        *(u32x2*)(dst + CL_W + (size_t)((r * 4 + (wave >> 1)) * 64 + lane) * 16 + (wave & 1) * 8) = t8;
                    }
                    LDS_WAIT();
                }
            }
        }
        __syncthreads();
    }
}

DI void gdn_scan_phase(unsigned char* ws, LAS unsigned char* lds, int G, int bx) {
    int tid = threadIdx.x; asm volatile("" : "+v"(tid));
    const int lane = tid & 63, wave = __builtin_amdgcn_readfirstlane(tid >> 6), gw = bx * NWAVES + wave, NGW = G * NWAVES, gtid = bx * NTHR + tid, NGT = G * NTHR;
    (void)lane; (void)wave; (void)gw; (void)NGW; (void)gtid; (void)NGT;
    const unsigned char* CL = ws + WS_R0; const float* GEND = (const float*)(ws + WS_GEND);
    const int fr = lane & 15, fq = lane >> 4, th = wave >> 2, n = wave & 3;
    for (int u0 = bx; u0 < 256; u0 += G) {
        const int u = (G % 16 == 0) ? ((u0 & ~15) | ((u0 & 7) << 1) | ((u0 >> 3) & 1)) : u0;
        const int b = u >> 5, h = (u >> 2) & 7, dir = (u >> 1) & 1, hv = u & 1; const int cbase = ((b * 8 + h) * 2 + dir) * 36;
        bf16* OX = (bf16*)(ws + WS_R1) + (size_t)dir * T * D;
        f32x4 S[8];
#pragma unroll
        for (int r = 0; r < 8; ++r) S[r] = (f32x4){0.f, 0.f, 0.f, 0.f};
#define GS_LOAD(step, bufi) do { const int blk_ = dir ? ((step) < 4 ? 3 - (step) : 39 - (step)) : (step); const unsigned char* src_ = CL + (size_t)(cbase + blk_) * CL_BYTES; \
        _Pragma("unroll") for (int i_ = 0; i_ < 8; ++i_) { const unsigned char* g_ = (i_ < 7) ? src_ + (size_t)(tid + 512 * i_) * 16 : src_ + CL_UT + (size_t)hv * 8192 + (size_t)tid * 16; \
            __builtin_amdgcn_global_load_lds((const unsigned*)g_, (LAS unsigned*)(lds + (bufi) * 65536 + (wave * 64 + 512 * i_) * 16), 16, 0, 0); } } while (0)
        GS_LOAD(0, 0);
        LAS float* gtab = (LAS float*)(lds + 131072 + 512);
        if (tid < 36) { const int blk_ = dir ? (tid < 4 ? 3 - tid : 39 - tid) : tid; gtab[tid] = GEND[cbase + blk_]; }
        VM_WAIT(); __syncthreads();
        for (int step = 0; step < 36; ++step) {
            const int blk = dir ? (step < 4 ? 3 - step : 39 - step) : step;
            if (step + 1 < 36) GS_LOAD(step + 1, (step + 1) & 1);
            const LAS unsigned char* bb = lds + (step & 1) * 65536;
            const float gend = gtab[step];
            if (wave < 4) {
            bf16x8 sb[4];
#pragma unroll
            for (int ks = 0; ks < 4; ++ks) sb[ks] = pack_frag(S[2 * ks], S[2 * ks + 1]);
            f32x4 vn[4];
#pragma unroll
            for (int tb = 0; tb < 4; ++tb) { f32x4 acc = (f32x4){0.f, 0.f, 0.f, 0.f};
#pragma unroll
                for (int ks = 0; ks < 4; ++ks) acc = __builtin_amdgcn_mfma_f32_16x16x32_bf16(*(const LAS bf16x8*)(bb + CL_W + ((tb * 4 + ks) * 64 + lane) * 16), sb[ks], acc, 0, 0, 0);
                const u32x2 up = *(const LAS u32x2*)(bb + 57344 + ((n * 4 + tb) * 64 + lane) * 8);
                vn[tb][0] = bf2f(up.x & 0xffffu) - acc[0]; vn[tb][1] = bf2f(up.x >> 16) - acc[1]; vn[tb][2] = bf2f(up.y & 0xffffu) - acc[2]; vn[tb][3] = bf2f(up.y >> 16) - acc[3]; }
            bf16x8 vb[2];
            vb[0] = pack_frag(vn[0], vn[1]); vb[1] = pack_frag(vn[2], vn[3]);
#pragma unroll
            for (int tq = 0; tq < 4; ++tq) { const int tb = tq; f32x4 acc = (f32x4){0.f, 0.f, 0.f, 0.f};
#pragma unroll
                for (int ks = 0; ks < 4; ++ks) acc = __builtin_amdgcn_mfma_f32_16x16x32_bf16(*(const LAS bf16x8*)(bb + CL_QG + ((tb * 4 + ks) * 64 + lane) * 16), sb[ks], acc, 0, 0, 0);
#pragma unroll
                for (int ks = 0; ks < 2; ++ks) acc = __builtin_amdgcn_mfma_f32_16x16x32_bf16(*(const LAS bf16x8*)(bb + CL_ATT + ((tb * 2 + ks) * 64 + lane) * 16), vb[ks], acc, 0, 0, 0);
#pragma unroll
                for (int j = 0; j < 4; ++j) { const int i = tb * 16 + fq * 4 + j, s = blk * 64 + (dir ? 63 - i : i);
                    OX[((size_t)b * LT + s) * D + h * 128 + (hv * 4 + n) * 16 + fr] = (bf16)f2bf(acc[j]); } }
#pragma unroll
            for (int rb = 0; rb < 8; ++rb) { f32x4 acc = S[rb] * gend;
#pragma unroll
                for (int ks = 0; ks < 2; ++ks) acc = __builtin_amdgcn_mfma_f32_16x16x32_bf16(*(const LAS bf16x8*)(bb + CL_KDT + ((rb * 2 + ks) * 64 + lane) * 16), vb[ks], acc, 0, 0, 0);
                S[rb] = acc; }
            }
            VM_WAIT(); __syncthreads();
        }
#undef GS_LOAD
    }
}

constexpr int NPH = 45, LDS_BYTES = 147456, MISC_OFF = 131072;
#ifndef PHSEL
#define PHSEL 0xffffffffu
#endif
#define PHON(b) ((PHSEL >> (b)) & 1u)
#ifndef DUPSEL
#define DUPSEL 0u
#endif
#ifndef DUPN
#define DUPN 2
#endif
#define NREP(b) (((DUPSEL >> (b)) & 1u) ? DUPN : 1)
#define IN(k) (lo <= (k) && (k) < hi)
#define SEAM(k) do { if (IN(k) && IN((k) + 1)) xcd_barrier(bar); } while (0)
template <int lp>
DI void layer_pair(const Args& args, unsigned char* ws, LAS unsigned char* lds, const int G, const int bx, const XcdBarrier& bar, const int lo, const int hi) {
    bf16* const H = (bf16*)(ws + WS_H); bf16* const XS = (bf16*)(ws + WS_XS); const float* const MOD = (const float*)(ws + WS_MOD);
    unsigned char* const wb = ws + WS_W; unsigned char* const wo = ws + WS_WO; unsigned char* const r0 = ws + WS_R0; unsigned char* const r1 = ws + WS_R1;
    const int tid = threadIdx.x;

        const int pb = 2 + 21 * lp, le = 2 * lp, lodd = 2 * lp + 1;
        if (PHON(1) && IN(pb + 0)) { if (lp == 0) convert_layer(args, ws, le, lds, G, bx);   norm_phase(args, ws, le, 0, G, bx); }
        SEAM(pb + 0);
        if (PHON(2) && IN(pb + 1)) { for (int rep_ = 0; rep_ < NREP(2); ++rep_) { pg8::DenseOrder S; S.init(H, D, (const bf16*)(wb + WE_IN), D, T, EVEN_INP, G, bx); EpiStoreBf16 E{(bf16*)(r0 + RE_P), EVEN_INP};
            pg8::gemm_phase<EpiStoreBf16, pg8::DenseOrder, D, D, D>(lds, S, E);  } }
        SEAM(pb + 1);
        if (PHON(3) && IN(pb + 2)) { for (int rep_ = 0; rep_ < NREP(3); ++rep_) { even_mid_phase(args, ws, le, G, bx);  } }
        SEAM(pb + 2);
        if (PHON(11) && IN(pb + 3)) { for (int rep_ = 0; rep_ < NREP(11); ++rep_) { pg8::DenseOrder S; S.init((const bf16*)(r0 + RE_A2), UP_K, (const bf16*)(wb + WE_UP), UP_K, T, UP_N, G, bx);
            EpiUp E{(bf16*)(r0 + RE_Q), (bf16*)(r0 + RE_KN), (bf16*)(r0 + RE_VT), (const float*)(ws + WS_ROPE), (const float*)(ws + WS_ROPE) + 2048 * 16};
            pg8::gemm_phase<EpiUp, pg8::DenseOrder, UP_K, UP_K, UP_K>(lds, S, E);  } }
        SEAM(pb + 3);
        if (PHON(4) && IN(pb + 4)) { for (int rep_ = 0; rep_ < NREP(4); ++rep_) { attn_phase(ws, lds, G, bx);  } }
        SEAM(pb + 4);
        if (PHON(12) && IN(pb + 5)) { pg8::DenseOrder S; S.init((const bf16*)(r0 + RE_MIX), D, (const bf16*)(wb + WE_OUT), D, T, D, G, bx); EpiResid E{XS, MOD + (size_t)le * 9 * 6144 + 2 * 1024};
            pg8::gemm_phase<EpiResid, pg8::DenseOrder, D, D, D>(lds, S, E);
            if (bx >= 32) convert_moe(args, ws, lodd, lds, (bx - 32) * NWAVES + __builtin_amdgcn_readfirstlane(tid >> 6), (G - 32) * NWAVES, 0, MOE_Q1); }
        SEAM(pb + 5);
        if (PHON(1) && IN(pb + 6)) { for (int rep_ = 0; rep_ < NREP(16); ++rep_) norm_phase(args, ws, le, 1, G, bx); }
        SEAM(pb + 6);
        if (PHON(13) && IN(pb + 7)) { for (int rep_ = 0; rep_ < NREP(13); ++rep_) { pg8::DenseOrder S; S.init(H, D, (const bf16*)(wb + WE_W1), D, T, 2 * FFN_F, G, bx); EpiSwiglu E{(bf16*)(r0 + RE_ACT), FFN_F};
            pg8::gemm_phase<EpiSwiglu, pg8::DenseOrder, D, D, D>(lds, S, E);  } }
        SEAM(pb + 7);
        if (PHON(12) && IN(pb + 8)) { pg8::DenseOrder S; S.init((const bf16*)(r0 + RE_ACT), FFN_F, (const bf16*)(wb + WE_W2), FFN_F, T, D, G, bx); EpiResid E{XS, MOD + (size_t)le * 9 * 6144 + 5 * 1024};
            pg8::gemm_phase<EpiResid, pg8::DenseOrder, FFN_F, FFN_F, FFN_F>(lds, S, E);
            if (bx >= 32) { convert_moe(args, ws, lodd, lds, (bx - 32) * NWAVES + __builtin_amdgcn_readfirstlane(tid >> 6), (G - 32) * NWAVES, MOE_Q1, MOE_ITEMS); convert_layer(args, ws, lodd, lds, G - 32, bx - 32); } }
        SEAM(pb + 8);
        if (PHON(1) && IN(pb + 9)) { norm_phase(args, ws, lodd, 0, G, bx); }
        SEAM(pb + 9);
        if (PHON(14) && IN(pb + 10)) { for (int rep_ = 0; rep_ < NREP(14); ++rep_) { pg8::DenseOrder S; S.init(H, D, (const bf16*)(wo + WO_IN), D, T, ODD_INP, G, bx); EpiOddIn E{(bf16*)r0, (bf16*)(ws + WS_R2), (float*)(ws + WS_AB)};
            pg8::gemm_phase<EpiOddIn, pg8::DenseOrder, D, D, D>(lds, S, E);  } }
        SEAM(pb + 10);
        if (PHON(5) && IN(pb + 11)) { for (int rep_ = 0; rep_ < NREP(5); ++rep_) { odd_mid_phase(args, ws, lodd, lds, G, bx);  } }
        SEAM(pb + 11);
        if (PHON(6) && IN(pb + 12)) { for (int rep_ = 0; rep_ < NREP(6); ++rep_) { gdn_chunk_phase(ws, lds, G, bx);  } }
        SEAM(pb + 12);
        if (PHON(7) && IN(pb + 13)) { for (int rep_ = 0; rep_ < NREP(7); ++rep_) { gdn_scan_phase(ws, lds, G, bx);  } }
        SEAM(pb + 13);
        if (PHON(8) && IN(pb + 14)) { for (int rep_ = 0; rep_ < NREP(8); ++rep_) { odd_post_phase(args, ws, lodd, G, bx);  } }
        SEAM(pb + 14);
        if (PHON(12) && IN(pb + 15)) { pg8::DenseOrder S; S.init((const bf16*)r1 + (size_t)2 * T * D, D, (const bf16*)(wo + WO_OUT), D, T, D, G, bx, lodd == 3); EpiResid E{XS, MOD + (size_t)lodd * 9 * 6144 + 2 * 1024};
            pg8::gemm_phase<EpiResid, pg8::DenseOrder, D, D, D>(lds, S, E);
            if (lp == 0 && bx >= 32) convert_layer(args, ws, 2, lds, G - 32, bx - 32); }
        SEAM(pb + 15);
        if (PHON(1) && IN(pb + 16)) { norm_phase(args, ws, lodd, 1, G, bx); }
        SEAM(pb + 16);
        if (PHON(1) && IN(pb + 17)) { route_assign_phase(ws, lodd, G, bx); }
        SEAM(pb + 17);
        if (IN(pb + 18) || IN(pb + 19) || IN(pb + 20)) { LAS int* tab = (LAS int*)(lds + MISC_OFF + 64);
            if (tid < NEXP) tab[tid] = (int)__hip_atomic_load((unsigned*)(ws + WS_CTL) + CW_CNT + (lp * 8 + tid) * 64, __ATOMIC_RELAXED, __HIP_MEMORY_SCOPE_AGENT);
            __syncthreads(); }
        if (PHON(9) && IN(pb + 18)) { for (int rep_ = 0; rep_ < NREP(9); ++rep_) { MoeOrder<true> S{H, (const bf16*)(wo + WO_W1), D, D, (size_t)2 * MOE_F * D, (const int*)(ws + WS_LIST), (const LAS int*)(lds + MISC_OFF + 64), 28, G, (G % 8 == 0) ? (bx & 7) * (G >> 3) + (bx >> 3) : bx, 0x7fffffff}; EpiSwiglu E{(bf16*)r0, MOE_F};
            pg8::gemm_phase<EpiSwiglu, MoeOrder<true>, D, D, D>(lds, S, E);  } }
        SEAM(pb + 18);
        int moeU = 0;
        if (IN(pb + 19) || IN(pb + 20)) { const LAS int* tabp = (const LAS int*)(lds + MISC_OFF + 64);
#pragma unroll
            for (int e = 0; e < NEXP; ++e) moeU += ((tabp[e] + 255) >> 8) * 4; }
        const int moeFull = (moeU / G) * G, moeR = moeU - moeFull, moeS = (moeR == 0) ? 1 : (4 * moeR <= G ? 4 : (2 * moeR <= G ? 2 : 1));
        bf16* const PB = (bf16*)(ws + WS_END);
        if (PHON(10) && IN(pb + 19)) { for (int rep_ = 0; rep_ < NREP(10); ++rep_) {
            MoeOrder<false> S{(const bf16*)r0, (const bf16*)(wo + WO_W2), MOE_F, MOE_F, (size_t)D * MOE_F, (const int*)(ws + WS_LIST), (const LAS int*)(lds + MISC_OFF + 64), 4, G, (G % 8 == 0) ? (bx & 7) * (G >> 3) + (bx >> 3) : bx, moeS > 1 ? moeFull : moeU};
            { EpiMoeDown E{(bf16*)r1, (const float*)(ws + WS_GW)}; pg8::gemm_phase<EpiMoeDown, MoeOrder<false>, MOE_F, MOE_F, MOE_F>(lds, S, E); }
            if (moeS == 2) { MoeTailOrder TS{S, moeFull, moeR, 2, MOE_F / 2}; EpiMoeDownPart E{PB, (const float*)(ws + WS_GW)}; pg8::gemm_phase<EpiMoeDownPart, MoeTailOrder, MOE_F / 2, MOE_F, MOE_F>(lds, TS, E); }
            else if (moeS == 4) { MoeTailOrder TS{S, moeFull, moeR, 4, MOE_F / 4}; EpiMoeDownPart E{PB, (const float*)(ws + WS_GW)}; pg8::gemm_phase<EpiMoeDownPart, MoeTailOrder, MOE_F / 4, MOE_F, MOE_F>(lds, TS, E); }
        } }
        SEAM(pb + 19);
        if (DBG_CHECK && PHON(10) && IN(pb + 20) && moeS > 1) {
            MoeOrder<false> S{(const bf16*)r0, (const bf16*)(wo + WO_W2), MOE_F, MOE_F, (size_t)D * MOE_F, (const int*)(ws + WS_LIST), (const LAS int*)(lds + MISC_OFF + 64), 4, G, bx, moeU};
            int tz = threadIdx.x; asm volatile("" : "+v"(tz));
            for (int it = bx * NTHR + tz; it < moeR * 8192; it += G * NTHR) { const int ut = it >> 13, r = (it >> 5) & 255, ch = it & 31; pg8::Unit u;
                if (!S.locate((long)moeFull + ut, u)) continue;
                if ((u.e >> 8) + r >= u.cnt) continue;
                f32x4 a0 = (f32x4){0.f, 0.f, 0.f, 0.f}, a1 = a0;
                for (int ks = 0; ks < moeS; ++ks) { const u32x4 p = *(const u32x4*)(PB + (((size_t)ks * 128 + ut) * 256 + r) * 256 + ch * 8);
                    a0[0] += bf2f(p.x & 0xffffu); a0[1] += bf2f(p.x >> 16); a0[2] += bf2f(p.y & 0xffffu); a0[3] += bf2f(p.y >> 16); a1[0] += bf2f(p.z & 0xffffu); a1[1] += bf2f(p.z >> 16); a1[2] += bf2f(p.w & 0xffffu); a1[3] += bf2f(p.w >> 16); }
                *(u32x4*)((bf16*)r1 + ((size_t)u.pm * 256 + r) * D + u.pn * 256 + ch * 8) = pack8(a0, a1); }
        }
        if (DBG_CHECK) SEAM(pb + 20);
    }
__global__ void __launch_bounds__(NTHR, 2) fwd_kernel(Args args) {
    extern __shared__ __attribute__((aligned(16))) unsigned char lds_raw[];
    LAS unsigned char* lds = (LAS unsigned char*)lds_raw;
    const int tid = threadIdx.x;
    const int G = gridDim.x, bx = blockIdx.x;
    unsigned char* ws = args.ws;
    volatile LAS unsigned* MISC = (volatile LAS unsigned*)(lds + MISC_OFF);
    if (tid < 256) MISC[tid] = 0u;
    __syncthreads();
    XcdBarrier bar = xcd_barrier_post((unsigned*)(ws + WS_CTL) + CW_BAR, MISC);
    const int lo = args.ph_lo, hi = args.ph_hi;
    bf16* const H = (bf16*)(ws + WS_H); bf16* const XS = (bf16*)(ws + WS_XS); const float* const MOD = (const float*)(ws + WS_MOD);
    unsigned char* const wb = ws + WS_W; unsigned char* const r0 = ws + WS_R0; unsigned char* const r1 = ws + WS_R1;

    if (PHON(0) && IN(0)) { prologue_mod_partial(args, ws, lds, G, bx); }
    SEAM(0);
    if (PHON(0) && IN(1)) { prologue_mod_reduce(args, ws, G, bx); }
    SEAM(1);
    layer_pair<0>(args, ws, lds, G, bx, bar, lo, hi);
    layer_pair<1>(args, ws, lds, G, bx, bar, lo, hi);
    if (PHON(1) && IN(44)) { norm_phase(args, ws, 3, 2, G, bx); }
#undef IN
#undef SEAM
}

#if DBG_CHECK
__device__ __forceinline__ unsigned dh(unsigned x) { x ^= x >> 16; x *= 0x7feb352du; x ^= x >> 15; x *= 0x846ca68bu; x ^= x >> 16; return x; }
__device__ __forceinline__ void rec(unsigned* chk, int ph, float actual, float expect, float flo) {
    float e = fabsf(actual - expect) / (fabsf(expect) + flo); if (!(e == e) || !(fabsf(actual) < 1e30f)) e = 1e30f;
    atomicMax(chk + ph, __float_as_uint(e));
}
__device__ __forceinline__ float ldbf(const bf16* p) { return bf2f(*p); }
__global__ void chk_kernel(Args a, int ph, int pre) {
    unsigned char* ws = a.ws; unsigned* chk = (unsigned*)(ws + WS_CTL) + CW_CHK; float* EX = (float*)(ws + WS_DBG);
    const int i = blockIdx.x * blockDim.x + threadIdx.x; const unsigned r = dh(i * 2654435761u + 12345u + ph * 977u);
    const bf16* H = (const bf16*)(ws + WS_H); const bf16* XS = (const bf16*)(ws + WS_XS); const float* MOD = (const float*)(ws + WS_MOD);
    unsigned char* r0 = ws + WS_R0; unsigned char* r1 = ws + WS_R1;
    const int t = r % T, b = t / LT, s = t % LT, mr = s < CTXL ? 8 : b; const unsigned r2 = dh(r + 77u);
    if (ph == 0) return;
    if (ph == 1) { if (pre) return; const int l = r2 & 3, rr = (r2 >> 2) % 9, n = (r2 >> 8) % 6144; float acc = a.in[LIN(l, 1)][n];
        for (int k = 0; k < 1024; ++k) { const float c = rr < 8 ? a.in[IN_C][rr * 1024 + k] : a.in[IN_CCTX][k]; acc += c / (1.f + expf(-c)) * a.in[LIN(l, 0)][(size_t)k * 6144 + n]; }
        rec(chk, ph, MOD[((size_t)l * 9 + rr) * 6144 + n], acc, 0.02f); return; }
    if (ph == NPH - 1) { if (pre) return; if (s < CTXL) return; const int c = r2 & 1023; const bf16* row; float ss = 0.f;
        const int4 tk = *(const int4*)(ws + WS_TOK + (size_t)t * 16); const unsigned* cw = (const unsigned*)(ws + WS_CTL) + CW_CNT + 1 * 8 * 64; int tb0 = 0, tb1 = 0, accT = 0;
        for (int e = 0; e < 8; ++e) { if (e == tk.x) tb0 = accT; if (e == tk.z) tb1 = accT; accT += ((int)cw[e * 64] + 255) >> 8; }
        const bf16* y0 = (const bf16*)r1 + ((size_t)tb0 * 256 + tk.y) * D, *y1 = (const bf16*)r1 + ((size_t)tb1 * 256 + tk.w) * D; row = XS + (size_t)t * D; float xc = 0.f;
        for (int k = 0; k < 1024; ++k) { const float v = ldbf(row + k) + MOD[((size_t)3 * 9 + mr) * 6144 + 5 * 1024 + k] * (ldbf(y0 + k) + ldbf(y1 + k)); ss += v * v; if (k == c) xc = v; }
        rec(chk, ph, a.out[((size_t)b * SEQ + (s - CTXL)) * D + c], xc * rsqrtf(ss / 1024.f + NORM_EPS) * a.in[IN_FINAL][c], 0.3f); return; }
    const int q0 = (ph - 2) % 21, q = q0 <= 16 ? q0 : q0 - 1, lp = (ph - 2) / 21, le = 2 * lp, lo = 2 * lp + 1;
    if (q0 == 17) return;
    if (q == 0 || q == 6 || q == 9 || q == 16) {
        if (pre) return; const int layer = (q == 0 || q == 6) ? le : lo, which = (q == 0 || q == 9) ? 0 : 1; const int c = r2 & 1023;
        const bf16* row = XS + (size_t)t * D; float ss = 0.f;
        for (int k = 0; k < 1024; ++k) ss += ldbf(row + k) * ldbf(row + k);
        const float* g = a.in[LIN(layer, which == 0 ? 2 : ((layer & 1) ? 9 : 10))]; const float* m = MOD + ((size_t)layer * 9 + mr) * 6144 + (which ? 3 * 1024 : 0);
        const float e = ldbf(row + c) * rsqrtf(ss / 1024.f + NORM_EPS) * g[c] * (1.f + m[1024 + c]) + m[c];
        rec(chk, ph, ldbf(H + (size_t)t * D + c), e, 0.3f);
        if (layer == 0 && which == 0) { const float xin = s < CTXL ? a.in[IN_CTX][((size_t)b * CTXL + s) * D + c] : a.in[IN_X][((size_t)b * SEQ + (s - CTXL)) * D + c]; rec(chk, ph, ldbf(row + c), xin, 0.05f); }
        return; }
    if (q == 1) { if (pre) return; const int c = r2 % EVEN_IN; float acc = 0.f; for (int k = 0; k < 1024; ++k) acc += ldbf(H + (size_t)t * D + k) * a.in[LIN(le, 3)][(size_t)k * EVEN_IN + c];
        rec(chk, ph, ldbf((const bf16*)(r0 + RE_P) + (size_t)t * EVEN_INP + c), acc, 0.3f); return; }
    if (q == 2) { if (pre) return; const bf16* P = (const bf16*)(r0 + RE_P); const int c = r2 & 511; const bool hp = (s != 0 && s != CTXL), hn = (s != CTXL - 1 && s != LT - 1);
        const float* cw = a.in[LIN(le, 4)]; const bf16* pr = P + (size_t)t * EVEN_INP; float y = cw[512 + c] * ldbf(pr + 512 + c) * ldbf(pr + 1024 + c);
        if (hp) y += cw[c] * ldbf(pr - EVEN_INP + 512 + c) * ldbf(pr - EVEN_INP + 1024 + c); if (hn) y += cw[1024 + c] * ldbf(pr + EVEN_INP + 512 + c) * ldbf(pr + EVEN_INP + 1024 + c);
        rec(chk, ph, ldbf((const bf16*)(r0 + RE_MIX) + (size_t)t * D + c), ldbf(pr + c) * y, 0.2f);
        { const int cc = r2 % 384; float ss = 0.f; const int base = cc < 256 ? 1536 : 1792, n = cc < 256 ? 256 : 128, ci = cc < 256 ? cc : cc - 256; for (int k = 0; k < n; ++k) { const float v = ldbf(pr + base + k); ss += v * v; }
          const float g = cc < 256 ? a.in[LIN(le, 5)][ci] : a.in[LIN(le, 7)][ci]; rec(chk, ph, ldbf((const bf16*)(r0 + RE_A2) + (size_t)t * UP_K + cc), ldbf(pr + base + ci) * rsqrtf(ss / n + NORM_EPS) * g, 0.2f); }
        { const int o = r2 & 31; const bf16* xr = pr + 1920;
          float outv = ldbf(xr + o);
          if (s >= CTXL) { const int pos = s - CTXL, seg = o >> 3, j = o & 7; const int ai = (seg < 2) ? j : 8 + j; const float rc = (seg < 2) ? (float)(pos >> 6) : (float)(pos & 63);
              const float ang = rc * powf(10000.f, -(float)j / 8.f), cs = cosf(ang), sn = sinf(ang); const float av = (seg < 2) ? ldbf(xr + j) : ldbf(xr + 16 + j), bv = (seg < 2) ? ldbf(xr + 8 + j) : ldbf(xr + 24 + j);
              outv = (seg == 0 || seg == 2) ? av * cs - bv * sn : bv * cs + av * sn; (void)ai; }
          const int seg = o >> 3, j = o & 7, ii = (seg < 2) ? j : 8 + j, ab = seg & 1; rec(chk, ph, ldbf((const bf16*)(ws + WS_KR) + (size_t)t * 32 + 2 * ii + ab), outv, 0.2f); }
        return; }
    if (q == 3) { if (pre) return; const bf16* A2 = (const bf16*)(r0 + RE_A2) + (size_t)t * UP_K; const int h = r2 & 7;
        { const int o = (r2 >> 3) % 96; float v; auto qdot = [&](int col) { float acc = 0.f; for (int k = 0; k < 256; ++k) acc += ldbf(A2 + k) * a.in[LIN(le, 6)][(size_t)k * 768 + col]; return acc; };
          int ipos;
          if (o < 64) { v = qdot(h * 96 + o); ipos = o; }
          else { const int oo = o - 64, seg = oo >> 3, j = oo & 7; const float av = qdot(h * 96 + 64 + ((seg < 2) ? j : 16 + j)), bv = qdot(h * 96 + 64 + ((seg < 2) ? 8 + j : 24 + j));
              if (s >= CTXL) { const int pos = s - CTXL; const float rc = (seg < 2) ? (float)(pos >> 6) : (float)(pos & 63), ang = rc * powf(10000.f, -(float)j / 8.f), cs = cosf(ang), sn = sinf(ang);
                  v = (seg == 0 || seg == 2) ? av * cs - bv * sn : bv * cs + av * sn; } else v = (seg == 0 || seg == 2) ? av : bv;
              ipos = 64 + 2 * ((seg < 2) ? j : 8 + j) + (seg & 1); }
          rec(chk, ph, ldbf((const bf16*)(r0 + RE_Q) + (size_t)t * 768 + h * 96 + ipos), v * QSCALE, 0.05f); }
        { const int o = (r2 >> 12) & 127; float acc = 0.f; for (int k = 0; k < 128; ++k) acc += ldbf(A2 + 256 + k) * a.in[LIN(le, 8)][(size_t)k * 1024 + h * 128 + o];
          const float got = o < 64 ? ldbf((const bf16*)(r0 + RE_KN) + (size_t)t * 512 + h * 64 + o) : ldbf((const bf16*)(r0 + RE_VT) + ((size_t)(b * 8 + h) * 64 + (o - 64)) * LT + s);
          rec(chk, ph, got, acc, 0.3f); }
        return; }
    if (q == 4) { if (pre) return; if (i >= 2048) return; const int h = r2 & 7, dv = (r2 >> 3) & 63; const bf16* Q = (const bf16*)(r0 + RE_Q) + (size_t)t * 768 + h * 96;
        const int nk = s < CTXL ? CTXL : LT; float mx = -3e38f;
        for (int pass = 0; pass < 2; ++pass) { float l = 0.f, o = 0.f;
            for (int k = 0; k < nk; ++k) { const size_t tk = (size_t)b * LT + k; float sc = 0.f; for (int d = 0; d < 64; ++d) sc += ldbf(Q + d) * ldbf((const bf16*)(r0 + RE_KN) + tk * 512 + h * 64 + d);
                for (int d = 0; d < 32; ++d) sc += ldbf(Q + 64 + d) * ldbf((const bf16*)(ws + WS_KR) + tk * 32 + d);
                if (pass == 0) mx = fmaxf(mx, sc); else { const float p = exp2f(sc - mx); l += p; o += p * ldbf((const bf16*)(r0 + RE_VT) + ((size_t)(b * 8 + h) * 64 + dv) * LT + k); } }
            if (pass == 1) rec(chk, ph, ldbf((const bf16*)(r0 + RE_MIX) + (size_t)t * D + 512 + h * 64 + dv), o / l, 0.1f); }
        return; }
    if (q == 5 || q == 8 || q == 15) {
        const int c = r2 & 1023; const bf16* A; const float* W; int K; const float* gate;
        if (q == 5) { A = (const bf16*)(r0 + RE_MIX) + (size_t)t * D; W = a.in[LIN(le, 9)]; K = 1024; gate = MOD + ((size_t)le * 9 + mr) * 6144 + 2 * 1024; }
        else if (q == 8) { A = (const bf16*)(r0 + RE_ACT) + (size_t)t * FFN_F; W = a.in[LIN(le, 12)]; K = FFN_F; gate = MOD + ((size_t)le * 9 + mr) * 6144 + 5 * 1024; }
        else { A = (const bf16*)r1 + (size_t)2 * T * D + (size_t)t * D; W = a.in[LIN(lo, 8)]; K = 1024; gate = MOD + ((size_t)lo * 9 + mr) * 6144 + 2 * 1024; }
        if (pre) { float acc = 0.f; for (int k = 0; k < K; ++k) acc += ldbf(A + k) * W[(size_t)k * 1024 + c]; EX[i] = ldbf(XS + (size_t)t * D + c) + gate[c] * acc; }
        else rec(chk, ph, ldbf(XS + (size_t)t * D + c), EX[i], 0.3f);
        return; }
    if (q == 7) { if (pre) return; const int c = r2 % FFN_F; float g = 0.f, u = 0.f; for (int k = 0; k < 1024; ++k) { const float hv = ldbf(H + (size_t)t * D + k); g += hv * a.in[LIN(le, 11)][(size_t)k * 2 * FFN_F + c]; u += hv * a.in[LIN(le, 11)][(size_t)k * 2 * FFN_F + FFN_F + c]; }
        rec(chk, ph, ldbf((const bf16*)(r0 + RE_ACT) + (size_t)t * FFN_F + c), g / (1.f + expf(-g)) * u, 0.2f); return; }
    if (q == 10) { if (pre) return; const int c = r2 % ODD_IN; float acc = 0.f; for (int k = 0; k < 1024; ++k) acc += ldbf(H + (size_t)t * D + k) * a.in[LIN(lo, 3)][(size_t)k * ODD_IN + c];
        const float got = c < 3072 ? ldbf((const bf16*)r0 + (size_t)t * 3072 + c) : (c < 4096 ? ldbf((const bf16*)(ws + WS_R2) + (size_t)t * 1024 + (c - 3072)) : ((const float*)(ws + WS_AB))[(size_t)t * 32 + (c - 4096)]);
        rec(chk, ph, got, acc, 0.3f); return; }
    if (q == 11) { if (pre) return; const bf16* QR = (const bf16*)r0; const int g = r2 % 3, h = (r2 >> 4) & 7, d = (r2 >> 8) & 127; const bool hp = (s != 0 && s != CTXL), hn = (s != CTXL - 1 && s != LT - 1);
        const float* cw = a.in[LIN(lo, 4)]; float ss = 0.f, mine = 0.f;
        for (int k = 0; k < 128; ++k) { const int c = g * 1024 + h * 128 + k; float y = cw[3072 + c] * ldbf(QR + (size_t)t * 3072 + c); if (hp) y += cw[c] * ldbf(QR + (size_t)(t - 1) * 3072 + c); if (hn) y += cw[6144 + c] * ldbf(QR + (size_t)(t + 1) * 3072 + c);
            const float v = y / (1.f + expf(-y)); ss += v * v; if (k == d) mine = v; }
        const float e = g == 2 ? mine : mine * rsqrtf(ss + NORM_EPS) * (g == 0 ? 0.08838834764831845f : 1.f);
        rec(chk, ph, ldbf((const bf16*)r1 + (size_t)t * 3072 + g * 1024 + h * 128 + d), e, g == 2 ? 0.05f : 0.005f);
        { const int idx = r2 & 15; const float av = ((const float*)(ws + WS_AB))[(size_t)t * 32 + idx], bt = ((const float*)(ws + WS_AB))[(size_t)t * 32 + 16 + idx]; const float z = av + a.in[LIN(lo, 6)][idx];
          rec(chk, ph, ((const float*)(ws + WS_GB))[(size_t)t * 32 + idx], -expf(a.in[LIN(lo, 5)][idx]) * (z > 20.f ? z : log1pf(expf(z))), 1e-3f); rec(chk, ph, ((const float*)(ws + WS_GB))[(size_t)t * 32 + 16 + idx], 1.f / (1.f + expf(-bt)), 1e-2f); }
        return; }
    if (q == 12) return;
    if (q == 13) {
        if (pre) return; if (blockIdx.x >= 6) return; const int dv = threadIdx.x; if (dv >= 128) return;
        const int cb = (blockIdx.x * 3) & 7, chh = (blockIdx.x * 5 + 1) & 7, dir = blockIdx.x & 1; const bf16* QN = (const bf16*)r1; const float* GB = (const float*)(ws + WS_GB);
        return; }
    if (q == 14) { if (pre) return; const int c = r2 & 1023, h = c >> 7; const bf16* OF = (const bf16*)r1 + (size_t)t * D, *OB = OF + (size_t)T * D; float ss = 0.f;
        for (int k = 0; k < 128; ++k) { const float v = ldbf(OF + h * 128 + k) + ldbf(OB + h * 128 + k); ss += v * v; }
        const float o = ldbf(OF + c) + ldbf(OB + c), gt = ldbf((const bf16*)(ws + WS_R2) + (size_t)t * D + c);
        rec(chk, ph, ldbf((const bf16*)r1 + (size_t)2 * T * D + (size_t)t * D + c), o * rsqrtf(ss / 128.f + NORM_EPS) * a.in[LIN(lo, 7)][c & 127] * (gt / (1.f + expf(-gt))), 0.1f); return; }
    if (q == 17 || q == 18) { if (pre) return; const unsigned* cw = (const unsigned*)(ws + WS_CTL) + CW_CNT + lp * 8 * 64; const int e = r2 & 7; int tb = 0; for (int k = 0; k < e; ++k) tb += ((int)cw[k * 64] + 255) >> 8;
        const int cnt = (int)cw[e * 64]; if (cnt == 0) return; const int pos = (r2 >> 3) % cnt; const int tok = ((const int*)(ws + WS_LIST))[(size_t)e * T + pos]; const size_t slot = (size_t)tb * 256 + pos;
        if (q == 17) { const int c = (r2 >> 16) % MOE_F; const float* W = a.in[LIN(lo, 11)] + (size_t)e * D * 2 * MOE_F; float g = 0.f, u = 0.f;
            for (int k = 0; k < 1024; ++k) { const float hv = ldbf(H + (size_t)tok * D + k); g += hv * W[(size_t)k * 2 * MOE_F + c]; u += hv * W[(size_t)k * 2 * MOE_F + MOE_F + c]; }
            rec(chk, ph, ldbf((const bf16*)r0 + slot * MOE_F + c), g / (1.f + expf(-g)) * u, 0.2f); }
        else { const int c = (r2 >> 16) & 1023; const float* W = a.in[LIN(lo, 12)] + (size_t)e * MOE_F * D; float acc = 0.f; for (int k = 0; k < MOE_F; ++k) acc += ldbf((const bf16*)r0 + slot * MOE_F + k) * W[(size_t)k * D + c];
            rec(chk, ph, ldbf((const bf16*)r1 + slot * D + c), acc * ((const float*)(ws + WS_GW))[(size_t)e * T + pos], 0.2f); }
        return; }
}
__global__ void __launch_bounds__(128) chk_gdn_ref(Args a, int lp) {
    unsigned char* ws = a.ws; float* EX = (float*)(ws + WS_END); const bf16* QN = (const bf16*)(ws + WS_R1); const float* GB = (const float*)(ws + WS_GB);
    const int j = blockIdx.x, b = (j * 3) & 7, h = (j * 5 + 1) & 7, dir = j & 1, dv = threadIdx.x; (void)lp;
    float S[128];
#pragma unroll
    for (int k = 0; k < 128; ++k) S[k] = 0.f;
    __shared__ float kq[256];
    for (int n = 0; n < LT; ++n) { const int s = dir ? (n < CTXL ? CTXL - 1 - n : LT - 1 - (n - CTXL)) : n; const size_t t = (size_t)b * LT + s;
        __syncthreads(); kq[dv] = ldbf(QN + t * 3072 + 1024 + h * 128 + dv); kq[128 + dv] = ldbf(QN + t * 3072 + h * 128 + dv); __syncthreads();
        const float g = GB[t * 32 + dir * 8 + h], beta = GB[t * 32 + 16 + dir * 8 + h], al = expf(g), v = ldbf(QN + t * 3072 + 2048 + h * 128 + dv);
        float ks = 0.f;
#pragma unroll
        for (int k = 0; k < 128; ++k) ks += kq[k] * S[k];
        float o = 0.f;
#pragma unroll
        for (int k = 0; k < 128; ++k) { S[k] = al * (S[k] - beta * kq[k] * ks) + beta * kq[k] * v; o += kq[128 + k] * S[k]; }
        EX[((size_t)j * LT + s) * 128 + dv] = o; }
}
__global__ void __launch_bounds__(128) chk_gdn_chunk(Args a, int ph) {
    unsigned char* ws = a.ws; unsigned* chk = (unsigned*)(ws + WS_CTL) + CW_CHK; const bf16* QN = (const bf16*)(ws + WS_R1); const float* GB = (const float*)(ws + WS_GB);
    __shared__ float gc[64], bt[64], Lm[64][65], xs[128][65];
    const unsigned r = dh(blockIdx.x * 7919u + 17u); const int b = r & 7, h = (r >> 3) & 7, dir = blockIdx.x & 1, blk = (r >> 8) % 36, tid = threadIdx.x;
    const size_t t0 = (size_t)b * LT + blk * 64; const unsigned char* cl = ws + WS_R0 + (size_t)(((b * 8 + h) * 2 + dir) * 36 + blk) * CL_BYTES;
#define TOK(i) (t0 + (dir ? 63 - (i) : (i)))
    if (tid == 0) { float acc = 0.f; for (int i = 0; i < 64; ++i) { acc += GB[TOK(i) * 32 + dir * 8 + h]; gc[i] = acc; bt[i] = GB[TOK(i) * 32 + 16 + dir * 8 + h]; } }
    __syncthreads();
    for (int e = tid; e < 4096; e += 128) { const int i = e >> 6, j = e & 63; float d = 0.f; for (int k = 0; k < 128; ++k) d += ldbf(QN + TOK(i) * 3072 + 1024 + h * 128 + k) * ldbf(QN + TOK(j) * 3072 + 1024 + h * 128 + k);
        Lm[i][j] = j < i ? bt[i] * d * expf(gc[i] - gc[j]) : 0.f; }
    __syncthreads();
    const bool isW = tid >= 64; const int col = isW ? 2 * (tid - 64) + 1 : 2 * tid;
    for (int i = 0; i < 64; ++i) { float x = isW ? ldbf(QN + TOK(i) * 3072 + 1024 + h * 128 + col) * bt[i] * expf(gc[i]) : ldbf(QN + TOK(i) * 3072 + 2048 + h * 128 + col) * bt[i];
        for (int j = 0; j < i; ++j) x -= Lm[i][j] * xs[tid][j];
        xs[tid][i] = x;
        float got;
        if (!isW) got = ldbf((const bf16*)(cl + CL_UT + (size_t)(((col >> 4) * 4 + (i >> 4)) * 64 + ((i & 15) >> 2) * 16 + (col & 15)) * 8 + (i & 3) * 2));
        else got = ldbf((const bf16*)(cl + CL_W + (size_t)(((i >> 4) * 4 + (col >> 5)) * 64 + ((col & 15) >> 2) * 16 + (i & 15)) * 16 + (4 * ((col & 31) >> 4) + (col & 3)) * 2));
        rec(chk, ph, got, x, 0.05f);
    }
    for (int e = tid; e < 2048; e += 128) { const unsigned rr = dh(e * 31u + blockIdx.x); const int i = rr & 63, dk = (rr >> 6) & 127, j = (rr >> 13) & 63;
        { const float ex = ldbf(QN + TOK(i) * 3072 + h * 128 + dk) * expf(gc[i]);
          rec(chk, ph, ldbf((const bf16*)(cl + CL_QG + (size_t)(((i >> 4) * 4 + (dk >> 5)) * 64 + ((dk & 15) >> 2) * 16 + (i & 15)) * 16 + (4 * ((dk & 31) >> 4) + (dk & 3)) * 2)), ex, 0.01f); }
        { const float ex = ldbf(QN + TOK(i) * 3072 + 1024 + h * 128 + dk) * expf(gc[63] - gc[i]);
          rec(chk, ph, ldbf((const bf16*)(cl + CL_KDT + (size_t)(((dk >> 4) * 2 + (i >> 5)) * 64 + ((i & 15) >> 2) * 16 + (dk & 15)) * 16 + (4 * ((i & 31) >> 4) + (i & 3)) * 2)), ex, 0.02f); }
        { float d = 0.f; for (int k = 0; k < 128; ++k) d += ldbf(QN + TOK(i) * 3072 + h * 128 + k) * ldbf(QN + TOK(j) * 3072 + 1024 + h * 128 + k);
          const float ex = j <= i ? d * expf(gc[i] - gc[j]) : 0.f;
          rec(chk, ph, ldbf((const bf16*)(cl + CL_ATT + (size_t)(((i >> 4) * 2 + (j >> 5)) * 64 + ((j & 15) >> 2) * 16 + (i & 15)) * 16 + (4 * ((j & 31) >> 4) + (j & 3)) * 2)), ex, 0.01f); }
    }
    if (tid == 0) rec(chk, ph, ((const float*)(ws + WS_GEND))[((b * 8 + h) * 2 + dir) * 36 + blk], expf(gc[63]), 0.01f);
#undef TOK
}
__global__ void chk_gdn_cmp(Args a, int ph) {
    unsigned char* ws = a.ws; unsigned* chk = (unsigned*)(ws + WS_CTL) + CW_CHK; const float* EX = (const float*)(ws + WS_END);
    const int j = blockIdx.x, b = (j * 3) & 7, h = (j * 5 + 1) & 7, dir = j & 1, dv = threadIdx.x; const bf16* OX = (const bf16*)(ws + WS_R1) + (size_t)dir * T * D;
    for (int s = 0; s < LT; ++s) rec(chk, ph, ldbf(OX + ((size_t)b * LT + s) * D + h * 128 + dv), EX[((size_t)j * LT + s) * 128 + dv], 0.1f);
}
__global__ void chk_report(Args a) {
    const unsigned* chk = (const unsigned*)(a.ws + WS_CTL) + CW_CHK; int bad = -1;
    for (int k = 0; k < NPH; ++k) if (__uint_as_float(chk[k]) > 0.1f) { bad = k; break; }
    if (bad < 0) return;
    const float c = exp2f((float)(bad + 1));
    for (size_t i = (size_t)blockIdx.x * blockDim.x + threadIdx.x; i < (size_t)NB * SEQ * D; i += (size_t)gridDim.x * blockDim.x) a.out[i] = c;
}
#endif

extern "C" void kernel_launch(void* const* d_in, const int* in_sizes, int n_in, void* d_out, int out_size, void* d_ws, size_t ws_size, hipStream_t stream) {
    static int grid = 0;
    if (grid == 0) {
        if (n_in != 57 || in_sizes[0] != NB * SEQ * D || out_size != NB * SEQ * D || ws_size < WS_END + 64 * MiB) { fprintf(stderr, "kernel_launch: unexpected shapes (n_in %d, in0 %d, out %d, ws %zu < %zu)\n", n_in, n_in > 0 ? in_sizes[0] : -1, out_size, ws_size, (size_t)WS_END); grid = -1; return; }
        int dev = 0, cus = 0, per_cu = 0;
        if (hipGetDevice(&dev) != hipSuccess || hipDeviceGetAttribute(&cus, hipDeviceAttributeMultiprocessorCount, dev) != hipSuccess) { grid = -1; return; }
        if (hipFuncSetAttribute((const void*)fwd_kernel, hipFuncAttributeMaxDynamicSharedMemorySize, LDS_BYTES) != hipSuccess) { fprintf(stderr, "kernel_launch: hipFuncSetAttribute failed\n"); grid = -1; return; }
        if (hipOccupancyMaxActiveBlocksPerMultiprocessor(&per_cu, (const void*)fwd_kernel, NTHR, LDS_BYTES) != hipSuccess || per_cu < 1) fprintf(stderr, "kernel_launch: occupancy query says %d\n", per_cu);
        (void)hipGetLastError();
        grid = cus;
    }
    if (grid < 0) return;
    (void)hipMemsetAsync((char*)d_ws + WS_CTL, 0, CTL_ZERO_BYTES, stream);
    Args a{};
    for (int i = 0; i < 57; ++i) a.in[i] = (const float*)d_in[i];
    a.out = (float*)d_out; a.ws = (unsigned char*)d_ws;
#if N_LAUNCH_MODE == 1
    a.ph_lo = 0; a.ph_hi = NPH;
    hipLaunchKernelGGL(fwd_kernel, dim3(grid), dim3(NTHR), LDS_BYTES, stream, a);
#else
    for (int k = 0; k < NPH; ++k) { a.ph_lo = k; a.ph_hi = k + 1;
#if DBG_CHECK
        hipLaunchKernelGGL(chk_kernel, dim3(64), dim3(256), 0, stream, a, k, 1);
#endif
        hipLaunchKernelGGL(fwd_kernel, dim3(grid), dim3(NTHR), LDS_BYTES, stream, a);
#if DBG_CHECK
        hipLaunchKernelGGL(chk_kernel, dim3(64), dim3(256), 0, stream, a, k, 0);
        if (k >= 2 && k < NPH - 1 && (k - 2) % 21 == 12) { hipLaunchKernelGGL(chk_gdn_chunk, dim3(16), dim3(128), 0, stream, a, k); hipLaunchKernelGGL(chk_gdn_ref, dim3(6), dim3(128), 0, stream, a, (k - 2) / 21); }
        if (k >= 2 && k < NPH - 1 && (k - 2) % 21 == 13) hipLaunchKernelGGL(chk_gdn_cmp, dim3(6), dim3(128), 0, stream, a, k);
#endif
    }
#if DBG_CHECK
    hipLaunchKernelGGL(chk_report, dim3(256), dim3(256), 0, stream, a);
#endif
#endif
}
```
